# Optimizing an MI355X kernel written in HIP

```python
import math
import jax, jax.numpy as jnp
from jax import lax
import numpy as np

D_MODEL = 1024
BATCH = 4
SEQ = 8192
DEPTH = 2

N_META = 16
D_ATTN = 512
D_REC = 512
D_MIX = D_ATTN + D_REC
ATTN_HEADS = 4
ATTN_HEAD_DIM = 64
V_HEAD_DIM = 2 * ATTN_HEAD_DIM
ROPE_DIM = ATTN_HEAD_DIM // 4
ROPE_THETA = 500000.0
REC_BLOCKS = 8
REC_BLOCK_DIM = D_REC // REC_BLOCKS
CONV_WIDTH = 4
LRU_C = 8.0
D_FF = -(-8 * D_MODEL // (3 * 256)) * 256
Q_BLOCK = 128
EPS = 1e-6
N_IN = 3 * D_ATTN + 2 * D_REC

kernel_name = "hymba_diffattn_rglru_hybrid"


def rms_norm(x, g):
    xf = x.astype(jnp.float32)
    y = xf * lax.rsqrt(jnp.mean(xf * xf, axis=-1, keepdims=True) + EPS)
    return (y * g.astype(jnp.float32)).astype(x.dtype)


def rope_tables(T):
    inv = ROPE_THETA ** (-jnp.arange(0, ROPE_DIM, 2, dtype=jnp.float32) / ROPE_DIM)
    ang = jnp.arange(T, dtype=jnp.float32)[:, None] * inv[None, :]
    return jnp.cos(ang), jnp.sin(ang)


def apply_partial_rope(x, cos, sin):
    half = ROPE_DIM // 2
    c = cos[None, :, None, None, :].astype(x.dtype)
    s = sin[None, :, None, None, :].astype(x.dtype)
    x1 = x[..., :half]
    x2 = x[..., half:ROPE_DIM]
    return jnp.concatenate([x1 * c - x2 * s, x2 * c + x1 * s, x[..., ROPE_DIM:]], axis=-1)


def diff_attention(q, k, v, lam):
    B, T, H = q.shape[:3]
    nb = -(-T // Q_BLOCK)
    Tp = nb * Q_BLOCK
    padw = ((0, 0), (0, Tp - T), (0, 0), (0, 0), (0, 0))
    q = jnp.pad(q, padw)
    k = jnp.pad(k, padw)
    v = jnp.pad(v, padw[:4])
    qb = q.reshape(B, nb, Q_BLOCK, H, 2, ATTN_HEAD_DIM).transpose(1, 0, 2, 3, 4, 5)
    starts = jnp.arange(nb) * Q_BLOCK
    kpos = jnp.arange(Tp)
    scale = ATTN_HEAD_DIM ** -0.5

    def one_block(args):
        qblk, start = args
        s = jnp.einsum('bqhcd,bkhcd->bhcqk', qblk, k,
                       preferred_element_type=jnp.float32) * scale
        qpos = start + jnp.arange(Q_BLOCK)
        s = jnp.where(qpos[:, None] >= kpos[None, :], s, -jnp.inf)
        p = jax.nn.softmax(s, axis=-1)
        a = p[:, :, 0] - lam * p[:, :, 1]
        return jnp.einsum('bhqk,bkhe->bqhe', a.astype(v.dtype), v)

    o = lax.map(one_block, (qb, starts))
    return o.transpose(1, 0, 2, 3, 4).reshape(B, Tp, H, V_HEAD_DIM)[:, :T]


def rg_lru_branch(xr, gate, conv_w, conv_b, w_rg, b_rg, w_ig, b_ig, lru_L):
    B, T, _ = xr.shape
    xc = lax.conv_general_dilated(
        xr, conv_w[:, None, :].astype(xr.dtype), window_strides=(1,),
        padding=[(CONV_WIDTH - 1, 0)], dimension_numbers=('NWC', 'WIO', 'NWC'),
        feature_group_count=D_REC) + conv_b.astype(xr.dtype)
    xb = xc.reshape(B, T, REC_BLOCKS, REC_BLOCK_DIM)
    r = jax.nn.sigmoid((jnp.einsum('btnd,nde->btne', xb, w_rg).reshape(B, T, D_REC)
                        + b_rg).astype(jnp.float32))
    i = jax.nn.sigmoid((jnp.einsum('btnd,nde->btne', xb, w_ig).reshape(B, T, D_REC)
                        + b_ig).astype(jnp.float32))
    log_a = LRU_C * r * jax.nn.log_sigmoid(lru_L.astype(jnp.float32))
    a = jnp.exp(log_a)
    mult = jnp.sqrt(jnp.maximum(-jnp.expm1(2.0 * log_a), 0.0))
    mult = jnp.where(jnp.arange(T)[None, :, None] == 0, 1.0, mult)
    u = mult * i * xc.astype(jnp.float32)

    def combine(left, right):
        a1, b1 = left
        a2, b2 = right
        return a1 * a2, a2 * b1 + b2

    _, h = lax.associative_scan(combine, (a, u), axis=1)
    y = h * jax.nn.gelu(gate.astype(jnp.float32))
    return y.astype(xr.dtype)


def setup_inputs(seed: int = 0) -> dict:
    key = jax.random.key(seed)
    ks = jax.random.split(key, 24)
    f32 = jnp.float32
    L = DEPTH

    def nrm(k, shape, scale):
        return jax.random.normal(k, shape, f32) * scale

    u = jax.random.uniform(ks[15], (L, D_REC), f32, 0.9, 0.999)
    s = u ** (1.0 / LRU_C)
    lru_L = jnp.log(s) - jnp.log1p(-s)
    return {
        "x": nrm(ks[0], (BATCH, SEQ, D_MODEL), 1.0),
        "meta_tokens": nrm(ks[1], (N_META, D_MODEL), 1.0),
        "norm_mix_g": 1.0 + nrm(ks[2], (L, D_MODEL), 0.02),
        "w_in": nrm(ks[3], (L, D_MODEL, N_IN), D_MODEL ** -0.5),
        "q_norm_g": 1.0 + nrm(ks[4], (L, ATTN_HEAD_DIM), 0.02),
        "k_norm_g": 1.0 + nrm(ks[5], (L, ATTN_HEAD_DIM), 0.02),
        "lambda_q1": nrm(ks[6], (L, ATTN_HEAD_DIM), 0.1),
        "lambda_k1": nrm(ks[7], (L, ATTN_HEAD_DIM), 0.1),
        "lambda_q2": nrm(ks[8], (L, ATTN_HEAD_DIM), 0.1),
        "lambda_k2": nrm(ks[9], (L, ATTN_HEAD_DIM), 0.1),
        "subln_g": 1.0 + nrm(ks[10], (L, V_HEAD_DIM), 0.02),
        "conv_w": nrm(ks[11], (L, CONV_WIDTH, D_REC), CONV_WIDTH ** -0.5),
        "conv_b": nrm(ks[12], (L, D_REC), 0.01),
        "w_rg": nrm(ks[13], (L, REC_BLOCKS, REC_BLOCK_DIM, REC_BLOCK_DIM), REC_BLOCK_DIM ** -0.5),
        "b_rg": nrm(ks[14], (L, D_REC), 0.01),
        "w_ig": nrm(ks[16], (L, REC_BLOCKS, REC_BLOCK_DIM, REC_BLOCK_DIM), REC_BLOCK_DIM ** -0.5),
        "b_ig": nrm(ks[17], (L, D_REC), 0.01),
        "lru_L": lru_L,
        "rec_norm_g": 1.0 + nrm(ks[18], (L, D_REC), 0.02),
        "w_out": nrm(ks[19], (L, D_MIX, D_MODEL), D_MIX ** -0.5),
        "norm_ffn_g": 1.0 + nrm(ks[20], (L, D_MODEL), 0.02),
        "w_gu": nrm(ks[21], (L, D_MODEL, 2 * D_FF), D_MODEL ** -0.5),
        "w_down": nrm(ks[22], (L, D_FF, D_MODEL), D_FF ** -0.5),
    }


def reference(x, meta_tokens, norm_mix_g, w_in, q_norm_g, k_norm_g, lambda_q1, lambda_k1,
              lambda_q2, lambda_k2, subln_g, conv_w, conv_b, w_rg, b_rg, w_ig, b_ig, lru_L,
              rec_norm_g, w_out, norm_ffn_g, w_gu, w_down):
    B = x.shape[0]
    meta = jnp.broadcast_to(meta_tokens.astype(x.dtype)[None], (B, N_META, D_MODEL))
    h = jnp.concatenate([meta, x], axis=1)
    T = h.shape[1]
    cos, sin = rope_tables(T)
    splits = [D_ATTN, 2 * D_ATTN, 3 * D_ATTN, 3 * D_ATTN + D_REC]

    for l in range(DEPTH):
        lam_init = 0.8 - 0.6 * math.exp(-0.3 * l)
        hn = rms_norm(h, norm_mix_g[l])
        proj = hn @ w_in[l]
        q, k, v, xr, gate = jnp.split(proj, splits, axis=-1)
        q = q.reshape(B, T, ATTN_HEADS, 2, ATTN_HEAD_DIM)
        k = k.reshape(B, T, ATTN_HEADS, 2, ATTN_HEAD_DIM)
        v = v.reshape(B, T, ATTN_HEADS, V_HEAD_DIM)
        q = apply_partial_rope(rms_norm(q, q_norm_g[l]), cos, sin)
        k = apply_partial_rope(rms_norm(k, k_norm_g[l]), cos, sin)
        lam = (jnp.exp(jnp.sum(lambda_q1[l].astype(jnp.float32) * lambda_k1[l].astype(jnp.float32)))
               - jnp.exp(jnp.sum(lambda_q2[l].astype(jnp.float32) * lambda_k2[l].astype(jnp.float32)))
               + lam_init)
        o_attn = diff_attention(q, k, v, lam)
        o_attn = (rms_norm(o_attn, subln_g[l]) * (1.0 - lam_init)).reshape(B, T, D_ATTN)
        o_rec = rg_lru_branch(xr, gate, conv_w[l], conv_b[l], w_rg[l], b_rg[l],
                              w_ig[l], b_ig[l], lru_L[l])
        o_rec = rms_norm(o_rec, rec_norm_g[l])
        h = h + jnp.concatenate([o_attn, o_rec], axis=-1) @ w_out[l]
        hn = rms_norm(h, norm_ffn_g[l])
        g, u = jnp.split(hn @ w_gu[l], [D_FF], axis=-1)
        h = h + (jax.nn.silu(g) * u) @ w_down[l]

    return h[:, N_META:, :]
```

```cpp
#include <hip/hip_runtime.h>
#include <hip/hip_cooperative_groups.h>
#include <cstdio>
#include <cstdint>
#include <cmath>
namespace cg = cooperative_groups;
namespace pg8 {
#define PG8_LAS __attribute__((address_space(3)))
typedef unsigned short bf16_t;
typedef short bf16x8 __attribute__((ext_vector_type(8)));
typedef float f32x4 __attribute__((ext_vector_type(4)));
typedef unsigned u32x4 __attribute__((ext_vector_type(4)));
constexpr int BM = 256, BK = 64, HALF = 128, HTB = HALF * BK * 2  , STAGE_BYTES = 8 * HTB, NXCD = 8, WGM = 4;

__host__ __device__ __forceinline__ int lds_byte(int r, int c) { const int st = (r >> 4) * 2 + (c >> 5), rr = r & 15, cc = c & 31, ob = rr * 64 + cc * 2; return st * 1024 + (ob ^ (((ob >> 9) & 1) << 5)); }
__host__ __device__ __forceinline__ void stage_rc(int b, int& R, int& C) { const int st = b / 1024, sb = b % 1024, swz = sb ^ (((sb >> 9) & 1) << 5); R = (st >> 1) * 16 + swz / 64; C = (st & 1) * 32 + (swz % 64) / 2; }
__host__ __device__ __forceinline__ int perm32(int rho) { const int n = rho >> 4, i = rho & 15; return 8 * (i >> 2) + 4 * n + (i & 3); }

struct Unit { int pm, pn; };
struct Gemm { const bf16_t* A; const bf16_t* Bt; int M, N, K; };

struct StaticOrder {
    int nM, nN, nwg, G, c;
    __host__ __device__ void init(int M, int N, int G_, int c_) { nM = M / BM; nN = N / BM; nwg = nM * nN; G = G_; c = c_; }
    __host__ __device__ bool next(int i, Unit& u) const {
        const long L = (long)i * G + c; if (L >= nwg) return false;
        int wgid = (int)L; { const int q = nwg / NXCD, r = nwg % NXCD, xcd = wgid % NXCD, off = wgid / NXCD; wgid = (xcd < r ? xcd * (q + 1) : r * (q + 1) + (xcd - r) * q) + off; }
        const int nig = WGM * nN, gid = wgid / nig, fm = gid * WGM, gsz = (nM - fm) < WGM ? (nM - fm) : WGM;
        u.pm = fm + ((wgid % nig) % gsz); u.pn = (wgid % nig) / gsz; return true;
    }
    __device__ __forceinline__ void a_ready(const Unit&) const {}
    __device__ __forceinline__ void done(const Unit&) const {}
};

__device__ __forceinline__ unsigned cvt_pk_bf16(float lo, float hi) { unsigned r; asm volatile("v_cvt_pk_bf16_f32 %0, %1, %2" : "=v"(r) : "v"(lo), "v"(hi)); return r; }
typedef float f32x2 __attribute__((ext_vector_type(2)));
__device__ __forceinline__ f32x2 gelu_pk(f32x2 v) {
    const f32x2 av = __builtin_elementwise_abs(v), d = av * 0.2316418882f + 1.0f;
    f32x2 t; t.x = __builtin_amdgcn_rcpf(d.x); t.y = __builtin_amdgcn_rcpf(d.y);
    f32x2 q = t * 0.5307027145f + (-0.7265760135f); q = q * t + 0.7107068705f; q = q * t + (-0.142248368f); q = q * t + 0.127414796f; q = q * t;
    const f32x2 s = (v * v) * (-0.72134752044f);
    f32x2 e; e.x = __builtin_amdgcn_exp2f(s.x); e.y = __builtin_amdgcn_exp2f(s.y);
    const f32x2 m = v * (q * e), r = v - m;
    f32x2 o; o.x = v.x < 0.f ? m.x : r.x; o.y = v.y < 0.f ? m.y : r.y; return o;
}

template <class Epi, class Sched, bool ALIGN_EPI = false, bool SP2 = false>
__device__ __forceinline__ void gemm_phase(PG8_LAS unsigned char* lds, const Gemm g, const Sched& S, const Epi& E) {
    int tid_o = threadIdx.x; asm volatile("" : "+v"(tid_o));
    const int tid = tid_o, wid = __builtin_amdgcn_readfirstlane(tid >> 6), lane = tid & 63, wr = wid >> 2, wc = wid & 3, fr = lane & 15, fq = lane >> 4;
    const int K = g.K, nt = K / BK;
    unsigned voffA[2], voffB[2];
#pragma unroll
    for (int i = 0; i < 2; ++i) { int R, C; stage_rc(tid * 16 + i * 8192, R, C); const int Rb = Epi::PERM ? ((R & ~31) + perm32(R & 31)) : R;
        voffA[i] = (unsigned)(R * K + C) * 2u; voffB[i] = (unsigned)(Rb * K + C) * 2u; }
    const size_t kstep = (size_t)(BK * 2);
    const size_t hstep = (size_t)HALF * K * 2;
    const size_t tstep = 2 * hstep;
    const unsigned ldsw = (unsigned)wid * 1024u;
    const int aoff = lds_byte(wr * 64 + fr, fq * 8), boff = lds_byte(wc * 32 + fr, fq * 8);
#define PG8_SA(b, h) (((b) * 2 + (h)) * HTB)
#define PG8_SB(b, h) ((4 + (b) * 2 + (h)) * HTB)
#define PG8_STAGE(bufoff, gbase, voff) do { _Pragma("unroll") for (int _i = 0; _i < 2; ++_i) \
        __builtin_amdgcn_global_load_lds((const unsigned*)((const char*)(gbase) + (voff)[_i]), (PG8_LAS unsigned*)(lds + (bufoff) + ldsw + _i * 8192), 16, 0, 0); } while (0)
#define PG8_LDA(dst, b, h) do { _Pragma("unroll") for (int m = 0; m < 4; ++m) _Pragma("unroll") for (int k = 0; k < 2; ++k) dst[m][k] = *(const PG8_LAS bf16x8*)(lds + PG8_SA(b, h) + aoff + m * 2048 + k * 1024); } while (0)
#define PG8_LDB(dst, b, h) do { _Pragma("unroll") for (int n = 0; n < 2; ++n) _Pragma("unroll") for (int k = 0; k < 2; ++k) dst[n][k] = *(const PG8_LAS bf16x8*)(lds + PG8_SB(b, h) + boff + n * 2048 + k * 1024); } while (0)
#define PG8_MMA(ai, bj, At, Bt) do { __builtin_amdgcn_s_setprio(1); _Pragma("unroll") for (int m = 0; m < 4; ++m) _Pragma("unroll") for (int n = 0; n < 2; ++n) _Pragma("unroll") for (int k = 0; k < 2; ++k) \
        acc[ai][bj][m][n] = __builtin_amdgcn_mfma_f32_16x16x32_bf16(Bt[n][k], At[m][k], acc[ai][bj][m][n], 0, 0, 0); __builtin_amdgcn_s_setprio(0); } while (0)
#define PG8_WAIT_V(n) asm volatile("s_waitcnt vmcnt(" #n ")" ::: "memory")
#define PG8_WAIT_L(n) asm volatile("s_waitcnt lgkmcnt(" #n ")" ::: "memory")
#define PG8_BAR __builtin_amdgcn_s_barrier()
#define PG8_SCHED __builtin_amdgcn_sched_barrier(0)
    Unit cur, nxt; int ui = 0;
    if (!S.next(0, cur)) return;
    f32x4 acc[2][2][4][2];
#pragma unroll
    for (int a = 0; a < 2; ++a)
#pragma unroll
        for (int b = 0; b < 2; ++b)
#pragma unroll
            for (int m = 0; m < 4; ++m)
#pragma unroll
                for (int n = 0; n < 2; ++n) acc[a][b][m][n] = (f32x4){0.f, 0.f, 0.f, 0.f};
    bf16x8 At[4][2], B0[2][2], B1[2][2];
    const char* cA = (const char*)g.A + (size_t)cur.pm * tstep; const char* cB = (const char*)g.Bt + (size_t)cur.pn * tstep;
    S.a_ready(cur);
    { const auto pr0 = E.prep_issue(cur, tid); E.prep_commit(lds, pr0, 0, tid); }
    if constexpr (SP2) {
        PG8_STAGE(PG8_SB(0, 0), cB, voffB); PG8_STAGE(PG8_SB(0, 1), cB + hstep, voffB); PG8_STAGE(PG8_SA(0, 0), cA, voffA); PG8_STAGE(PG8_SA(0, 1), cA + hstep, voffA);
        if (wr == 1) PG8_BAR;
        PG8_WAIT_V(2); PG8_BAR;
        PG8_STAGE(PG8_SB(1, 0), cB + kstep, voffB); PG8_STAGE(PG8_SA(1, 0), cA + kstep, voffA); PG8_STAGE(PG8_SB(1, 1), cB + hstep + kstep, voffB);
        PG8_WAIT_V(6); PG8_BAR;
    } else {
        PG8_STAGE(PG8_SB(0, 0), cB, voffB); PG8_STAGE(PG8_SA(0, 0), cA, voffA); PG8_STAGE(PG8_SB(0, 1), cB + hstep, voffB); PG8_STAGE(PG8_SA(0, 1), cA + hstep, voffA);
        if (wr == 1) PG8_BAR;
        PG8_WAIT_V(4); PG8_BAR;
        PG8_STAGE(PG8_SB(1, 0), cB + kstep, voffB); PG8_STAGE(PG8_SA(1, 0), cA + kstep, voffA); PG8_STAGE(PG8_SB(1, 1), cB + hstep + kstep, voffB);
        PG8_WAIT_V(6); PG8_BAR;
    }
    for (;;) {
        const bool has_next = S.next(ui + 1, nxt);
        const char* nA = has_next ? (const char*)g.A + (size_t)nxt.pm * tstep : cA; const char* nB = has_next ? (const char*)g.Bt + (size_t)nxt.pn * tstep : cB;
        for (int t = 0; t < nt; t += 2) {
            const bool last = (t == nt - 2);
            const char* a1 = cA + (size_t)(t + 1) * kstep;
            const char* a2 = last ? nA : cA + (size_t)(t + 2) * kstep; const char* b2 = last ? nB : cB + (size_t)(t + 2) * kstep;
            const char* a3 = a2 + kstep; const char* b3 = b2 + kstep;
            if (last && has_next) S.a_ready(nxt);
            if constexpr (SP2) {
            PG8_LDB(B0, 0, 0); PG8_LDB(B1, 0, 1); PG8_SCHED; PG8_LDA(At, 0, 0); PG8_STAGE(PG8_SA(1, 1), a1 + hstep, voffA);
            PG8_WAIT_V(8); PG8_WAIT_L(0); PG8_BAR; PG8_MMA(0, 0, At, B0); PG8_MMA(0, 1, At, B1); PG8_BAR; PG8_SCHED;
            PG8_LDA(At, 0, 1); PG8_STAGE(PG8_SB(0, 0), b2, voffB); PG8_STAGE(PG8_SB(0, 1), b2 + hstep, voffB); PG8_STAGE(PG8_SA(0, 0), a2, voffA);
            PG8_WAIT_V(8); PG8_WAIT_L(0); PG8_BAR; PG8_MMA(1, 0, At, B0); PG8_MMA(1, 1, At, B1); PG8_BAR; PG8_SCHED;
            PG8_LDB(B0, 1, 0); PG8_LDB(B1, 1, 1); PG8_SCHED; PG8_LDA(At, 1, 0); PG8_STAGE(PG8_SA(0, 1), a2 + hstep, voffA);
            PG8_WAIT_V(8); PG8_WAIT_L(0); PG8_BAR; PG8_MMA(0, 0, At, B0); PG8_MMA(0, 1, At, B1); PG8_BAR; PG8_SCHED;
            PG8_LDA(At, 1, 1); PG8_STAGE(PG8_SB(1, 0), b3, voffB); PG8_STAGE(PG8_SB(1, 1), b3 + hstep, voffB); PG8_STAGE(PG8_SA(1, 0), a3, voffA);
            PG8_WAIT_V(8); PG8_WAIT_L(0); PG8_BAR; PG8_MMA(1, 0, At, B0); PG8_MMA(1, 1, At, B1); PG8_BAR; PG8_SCHED;
            } else {
            PG8_LDB(B0, 0, 0); PG8_SCHED; PG8_LDA(At, 0, 0); PG8_STAGE(PG8_SA(1, 1), a1 + hstep, voffA);
            PG8_WAIT_L(8); PG8_BAR; PG8_WAIT_L(0); PG8_MMA(0, 0, At, B0); PG8_BAR; PG8_SCHED;
            PG8_LDB(B1, 0, 1); PG8_STAGE(PG8_SB(0, 0), b2, voffB);
            PG8_BAR; PG8_WAIT_L(0); PG8_MMA(0, 1, At, B1); PG8_BAR;
            PG8_LDA(At, 0, 1); PG8_STAGE(PG8_SA(0, 0), a2, voffA);
            PG8_BAR; PG8_WAIT_L(0); PG8_MMA(1, 0, At, B0); PG8_BAR; PG8_SCHED;
            PG8_STAGE(PG8_SB(0, 1), b2 + hstep, voffB);
            PG8_WAIT_V(6); PG8_BAR; PG8_MMA(1, 1, At, B1); PG8_BAR;
            PG8_LDB(B0, 1, 0); PG8_SCHED; PG8_LDA(At, 1, 0); PG8_STAGE(PG8_SA(0, 1), a2 + hstep, voffA);
            PG8_WAIT_L(8); PG8_BAR; PG8_WAIT_L(0); PG8_MMA(0, 0, At, B0); PG8_BAR; PG8_SCHED;
            PG8_LDB(B1, 1, 1); PG8_STAGE(PG8_SB(1, 0), b3, voffB);
            PG8_BAR; PG8_WAIT_L(0); PG8_MMA(0, 1, At, B1); PG8_BAR;
            PG8_LDA(At, 1, 1); PG8_STAGE(PG8_SA(1, 0), a3, voffA);
            PG8_BAR; PG8_WAIT_L(0); PG8_MMA(1, 0, At, B0); PG8_BAR; PG8_SCHED;
            PG8_STAGE(PG8_SB(1, 1), b3 + hstep, voffB);
            PG8_WAIT_V(6); PG8_BAR; PG8_MMA(1, 1, At, B1); PG8_BAR;
            }
        }
        if constexpr (ALIGN_EPI) { if (wr == 0) PG8_BAR; }
        if constexpr (!Epi::AFTER_DRAIN) { const auto pr = E.prep_issue(has_next ? nxt : cur, tid); E.run(acc, cur, wr, wc, fr, fq, 2, lds, ui); E.prep_commit(lds, pr, ui + 1, tid); S.done(cur); }
#ifdef PROBE_EPI2
        if constexpr (Epi::IDEMP) { E.run(acc, cur, wr, wc, fr, fq, 2, lds, ui); }
#endif
        if (!has_next) break;
#pragma unroll
        for (int a = 0; a < 2; ++a)
#pragma unroll
            for (int b = 0; b < 2; ++b)
#pragma unroll
                for (int m = 0; m < 4; ++m)
#pragma unroll
                    for (int n = 0; n < 2; ++n) acc[a][b][m][n] = (f32x4){0.f, 0.f, 0.f, 0.f};
        cur = nxt; cA = nA; cB = nB; ++ui;
        if constexpr (ALIGN_EPI) { if (wr == 1) PG8_BAR; }
    }
    PG8_WAIT_V(0);
    if constexpr (!ALIGN_EPI) { if (wr == 0) PG8_BAR; }
    PG8_BAR;
    if constexpr (Epi::AFTER_DRAIN) { E.fused(acc, cur, wr, wc, fr, fq, lds, wid, lane); S.done(cur); }
#undef PG8_SA
#undef PG8_SB
#undef PG8_STAGE
#undef PG8_LDA
#undef PG8_LDB
#undef PG8_MMA
#undef PG8_WAIT_V
#undef PG8_WAIT_L
#undef PG8_BAR
#undef PG8_SCHED
}
}

using pg8::bf16_t; using pg8::bf16x8; using pg8::f32x4; using pg8::u32x4; using pg8::Unit;
typedef float f32x16 __attribute__((ext_vector_type(16)));
typedef short s16x4 __attribute__((ext_vector_type(4)));
typedef unsigned u32x2 __attribute__((ext_vector_type(2)));
#define LAS __attribute__((address_space(3)))
#define XB_TMO      128
#define XB_XCNT(j)  (256  + 64 * (j))
#define XB_XSUB(j)  (1280 + 64 * (j))
#define XB_XGEN(j)  (2304 + 64 * (j))
#define XB_TOP      3328
#define XB_TOPGEN   3392
#define XCD_BAR_WORDS 3456
#define XB_SPIN_CAP (1u << 18)

__device__ __forceinline__ unsigned xb_ld(unsigned* p)              { return __hip_atomic_load(p, __ATOMIC_RELAXED, __HIP_MEMORY_SCOPE_AGENT); }
__device__ __forceinline__ unsigned xb_add(unsigned* p, unsigned v) { return __hip_atomic_fetch_add(p, v, __ATOMIC_RELAXED, __HIP_MEMORY_SCOPE_AGENT); }
__device__ __forceinline__ unsigned xb_xcc_id() { return (unsigned)__builtin_amdgcn_s_getreg((3 << 11) | 20) & 0xFu; }
#define XB_SPIN(cond, bar) do { unsigned _sp = 0; while (cond) { __builtin_amdgcn_s_sleep(1); \
    if ((++_sp & 255u) == 0u) { if (xb_ld(&(bar)[XB_TMO])) break; if (_sp > XB_SPIN_CAP) { atomicAdd(&(bar)[XB_TMO], 1u); break; } } } } while (0)

struct XcdBarrier {
    unsigned* bar; unsigned x;
    volatile LAS unsigned* st;
};

__device__ __forceinline__ XcdBarrier xcd_barrier_post(unsigned* bar, volatile LAS unsigned* st) {
    XcdBarrier b; b.bar = bar; b.x = xb_xcc_id(); b.st = st;
    if (threadIdx.x == 0) (void)xb_add(&bar[XB_XCNT(b.x)], 1u);
    return b;
}
__device__ __forceinline__ void xcd_barrier_complete(unsigned* bar, unsigned x, unsigned& nloc, unsigned& nx) {
    const unsigned G = gridDim.x * gridDim.y * gridDim.z;
    unsigned sum, cnt, mine, sp = 0u;
    for (;;) {
        sum = 0u; cnt = 0u; mine = 0u;
#pragma unroll
        for (unsigned j = 0; j < 16; ++j) { const unsigned c = xb_ld(&bar[XB_XCNT(j)]); sum += c; cnt += (c > 0u) ? 1u : 0u; mine = (j == x) ? c : mine; }
        if (sum == G) break;
        __builtin_amdgcn_s_sleep(1);
        if ((++sp & 255u) == 0u) { if (xb_ld(&bar[XB_TMO])) break; if (sp > XB_SPIN_CAP) { atomicAdd(&bar[XB_TMO], 1u); break; } }
    }
    nloc = mine > 0u ? mine : 1u; nx = cnt > 0u ? cnt : 1u;
}

__device__ __forceinline__ void xcd_barrier(const XcdBarrier& b) {
    asm volatile("s_waitcnt vmcnt(0)" ::: "memory");
    __syncthreads();
    if (threadIdx.x == 0) {
        unsigned* bar = b.bar;
        __builtin_amdgcn_s_waitcnt(0);
        unsigned nloc = b.st[0], nx = b.st[1];
        if (nloc == 0u) { xcd_barrier_complete(bar, b.x, nloc, nx); b.st[0] = nloc; b.st[1] = nx; }
        const unsigned old = xb_add(&bar[XB_XSUB(b.x)], 1u);
        const unsigned gen = old / nloc;
        if (old + 1u == (gen + 1u) * nloc) {
            __builtin_amdgcn_fence(__ATOMIC_RELEASE, "agent");
            asm volatile("s_waitcnt vmcnt(0)" ::: "memory");
            const unsigned og = xb_add(&bar[XB_TOP], 1u);
            const unsigned tg = og / nx;
            if (og + 1u == (tg + 1u) * nx) xb_add(&bar[XB_TOPGEN], 1u);
            else XB_SPIN(xb_ld(&bar[XB_TOPGEN]) == tg, bar);
            __builtin_amdgcn_fence(__ATOMIC_ACQUIRE, "agent");
            xb_add(&bar[XB_XGEN(b.x)], 1u);
            asm volatile("s_waitcnt vmcnt(0)" ::: "memory");
        } else {
            XB_SPIN(xb_ld(&bar[XB_XGEN(b.x)]) == gen, bar);
            __builtin_amdgcn_fence(__ATOMIC_ACQUIRE, "agent");
            asm volatile("s_waitcnt vmcnt(0)" ::: "memory");
        }
    }
    __syncthreads();
}


constexpr int DM = 1024, TT = 8208, NBATCH = 4, MROWS = NBATCH * TT, MP = 33024, NIN = 2560, DFF = 2816, SEQ = 8192;
constexpr int NCH = 129;
constexpr int NQB = 65;
constexpr float EPS = 1e-6f;
__device__ constexpr float ROPE_INV[8] = {1.0f, 0.1939227432012558f, 0.03760603070259094f, 0.007292664609849453f, 0.0014142135623842478f, 0.00027424818836152554f, 5.318296098266728e-05f, 1.0313386155758053e-05f};
constexpr float C2 = 0.125f * 1.4426950408889634f;
constexpr size_t MiB = 1u << 20;
constexpr size_t WS_CTL = 0, CTL_BYTES = 32768;
constexpr size_t WS_W = 2 * MiB, W_LAYER = 24 * MiB, W_IN = 0, W_O = 5 * MiB, W_GU = 7 * MiB, W_D = 18 * MiB;
constexpr size_t WS_ROPE = 50 * MiB, WS_SSQ = 52 * MiB, WS_SUMA = 55 * MiB, WS_SUMH = 57 * MiB, WS_HM = 59 * MiB, WS_WG = 60 * MiB;
constexpr size_t WS_HB = 64 * MiB, WS_PJ = 130 * MiB, WS_HL = 292 * MiB, WS_CA = 325 * MiB, WS_MIX = 358 * MiB, WS_ACT = 130 * MiB, WS_END = 423 * MiB;
constexpr int LDS_BYTES = 147456, LDS_MISC = 139264;

typedef float f32x2_t __attribute__((ext_vector_type(2))); typedef __bf16 bf16x2_t __attribute__((ext_vector_type(2)));
__device__ __forceinline__ unsigned cvtpk(float lo, float hi) { f32x2_t v = {lo, hi}; bf16x2_t b = __builtin_convertvector(v, bf16x2_t); return __builtin_bit_cast(unsigned, b); }
__device__ __forceinline__ void row_bt(int r, int& b, int& t) { b = r / TT; t = r - b * TT; }
__device__ __forceinline__ float bf2f(unsigned short v) { return __uint_as_float((unsigned)v << 16); }
__device__ __forceinline__ u32x4 pack8(const f32x4 a, const f32x4 b) { u32x4 w; w.x = cvtpk(a[0], a[1]); w.y = cvtpk(a[2], a[3]); w.z = cvtpk(b[0], b[1]); w.w = cvtpk(b[2], b[3]); return w; }
__device__ __forceinline__ float row_rs(const float* SSQ, int r) {
    const f32x4* sp = (const f32x4*)(SSQ + (size_t)r * 16); const f32x4 a = sp[0], b = sp[1], c = sp[2], d = sp[3];
    const f32x4 s = (a + b) + (c + d); return rsqrtf(((s[0] + s[1]) + (s[2] + s[3])) * (1.0f / DM) + EPS);
}


constexpr int LDS_RSTAB = LDS_MISC + 2048;
struct PrepRegs { f32x4 a, b; };
__device__ __forceinline__ PrepRegs rs_issue(const float* SSQ, const Unit& u, int tid) { const f32x4* sp = (const f32x4*)(SSQ + (size_t)(u.pm * 256 + (tid >> 1)) * 16 + 8 * (tid & 1)); PrepRegs r; r.a = sp[0]; r.b = sp[1]; return r; }
__device__ __forceinline__ void rs_commit(LAS unsigned char* lds, const PrepRegs& r, int ui, int tid) {
    const f32x4 s4 = r.a + r.b; float s = (s4[0] + s4[1]) + (s4[2] + s4[3]); s += __shfl_xor(s, 1);
    if ((tid & 1) == 0) ((LAS float*)(lds + LDS_RSTAB))[(ui & 1) * 256 + (tid >> 1)] = rsqrtf(s * (1.0f / DM) + EPS);
}
struct EpiIn {
    static constexpr bool PERM = true, AFTER_DRAIN = false, IDEMP = true;
    bf16_t* PJ; const float* SSQ; const float* gq; const float* gk;
    __device__ __forceinline__ PrepRegs prep_issue(const Unit& u, int tid) const { return rs_issue(SSQ, u, tid); }
    __device__ __forceinline__ void prep_commit(LAS unsigned char* lds, const PrepRegs& r, int ui, int tid) const { rs_commit(lds, r, ui, tid); }
    __device__ __forceinline__ void run(const f32x4 (&acc)[2][2][4][2], const Unit& u, int wr, int wc, int fr, int fq, const int nai, LAS unsigned char* lds, const int ui) const {
        const LAS float* RT = (const LAS float*)(lds + LDS_RSTAB) + (ui & 1) * 256;
        const int pn = u.pn; const bool isqk = pn < 4;
        f32x4 gv[2][2];
#pragma unroll
        for (int bj = 0; bj < 2; ++bj)
#pragma unroll
            for (int n = 0; n < 2; ++n) gv[bj][n] = isqk ? *(const f32x4*)((pn < 2 ? gq : gk) + 32 * bj + 8 * fq + 4 * n) : (f32x4){1.f, 1.f, 1.f, 1.f};
        const float qs = (pn < 2) ? C2 : 1.f;
#pragma unroll
        for (int ai = 0; ai < nai; ++ai)
#pragma unroll
            for (int m = 0; m < 4; ++m) {
                const int r = u.pm * 256 + ai * 128 + wr * 64 + m * 16 + fr;
                const float rs = RT[ai * 128 + wr * 64 + m * 16 + fr];
                f32x4 v[2][2];
#pragma unroll
                for (int bj = 0; bj < 2; ++bj)
#pragma unroll
                    for (int n = 0; n < 2; ++n) v[bj][n] = acc[ai][bj][m][n] * rs;
                if (isqk) {
                    float q2 = 0.f;
#pragma unroll
                    for (int bj = 0; bj < 2; ++bj)
#pragma unroll
                        for (int n = 0; n < 2; ++n) { const f32x4 x = v[bj][n]; q2 += (x[0] * x[0] + x[1] * x[1]) + (x[2] * x[2] + x[3] * x[3]); }
                    q2 += __shfl_xor(q2, 16); q2 += __shfl_xor(q2, 32);
                    const float rn = rsqrtf(q2 * (1.0f / 64.0f) + EPS);
#pragma unroll
                    for (int bj = 0; bj < 2; ++bj)
#pragma unroll
                        for (int n = 0; n < 2; ++n) v[bj][n] = v[bj][n] * rn * gv[bj][n];
                    int b, t; row_bt(r, b, t);
#pragma unroll
                    for (int n = 0; n < 2; ++n) {
                        f32x4 o; o[0] = __shfl_xor(v[0][n][0], 16); o[1] = __shfl_xor(v[0][n][1], 16); o[2] = __shfl_xor(v[0][n][2], 16); o[3] = __shfl_xor(v[0][n][3], 16);
                        f32x4 c, s;
#pragma unroll
                        for (int i = 0; i < 4; ++i) {
                            const float angf = (float)t * ROPE_INV[4 * n + i];
                            const float pr_ = angf * 0.15915494f, er_ = __builtin_fmaf(angf, 0.15915494f, -pr_);
                            const float rev = __builtin_amdgcn_fractf(pr_) + __builtin_fmaf(angf, (float)(0.15915494309189535 - (double)0.15915494f), er_);
                            c[i] = __builtin_amdgcn_cosf(rev); s[i] = __builtin_amdgcn_sinf(rev); }
                        v[0][n] = (fq == 0) ? (v[0][n] * c - o * s) : ((fq == 1) ? (v[0][n] * c + o * s) : v[0][n]);
                    }
#pragma unroll
                    for (int bj = 0; bj < 2; ++bj)
#pragma unroll
                        for (int n = 0; n < 2; ++n) v[bj][n] = v[bj][n] * qs;
                }
                bf16_t* rowp = PJ + (size_t)r * NIN + pn * 256 + wc * 64 + 8 * fq;
#pragma unroll
                for (int bj = 0; bj < 2; ++bj) *(u32x4*)(rowp + 32 * bj) = pack8(v[bj][0], v[bj][1]);
            }
    }
};

struct EpiRes {
    static constexpr bool PERM = true, AFTER_DRAIN = false, IDEMP = false;
    float* out; bf16_t* HB; float* SSQ; int final;
    __device__ __forceinline__ void operator()(const f32x4 (&acc)[2][2][4][2], const Unit& u, int wr, int wc, int fr, int fq) const { run(acc, u, wr, wc, fr, fq, 2, nullptr, 0); }
    __device__ __forceinline__ int prep_issue(const Unit&, int) const { return 0; }
    __device__ __forceinline__ void prep_commit(LAS unsigned char*, int, int, int) const {}
    __device__ __forceinline__ void run(const f32x4 (&acc)[2][2][4][2], const Unit& u, int wr, int wc, int fr, int fq, const int nai, LAS unsigned char* lds, const int ui) const {
        const int pn = u.pn, col = pn * 256 + wc * 64 + 8 * fq;
#pragma unroll
        for (int ai = 0; ai < nai; ++ai) {
            if (u.pm * 256 + ai * 128 + wr * 64 >= MROWS) continue;
            u32x4 pre[4][2];
#pragma unroll
            for (int m = 0; m < 4; ++m) {
                const int r = u.pm * 256 + ai * 128 + wr * 64 + m * 16 + fr;
#pragma unroll
                for (int bj = 0; bj < 2; ++bj) pre[m][bj] = *(const u32x4*)(HB + (size_t)r * DM + col + 32 * bj);
            }
#pragma unroll
            for (int m = 0; m < 4; ++m) {
                const int r = u.pm * 256 + ai * 128 + wr * 64 + m * 16 + fr;
                int b, t; row_bt(r, b, t);
                float ss = 0.f;
#pragma unroll
                for (int bj = 0; bj < 2; ++bj) {
                    const u32x4 pw = pre[m][bj];
                    const f32x4 b0 = {__uint_as_float(pw[0] << 16), __uint_as_float(pw[0] & 0xffff0000u), __uint_as_float(pw[1] << 16), __uint_as_float(pw[1] & 0xffff0000u)};
                    const f32x4 b1 = {__uint_as_float(pw[2] << 16), __uint_as_float(pw[2] & 0xffff0000u), __uint_as_float(pw[3] << 16), __uint_as_float(pw[3] & 0xffff0000u)};
                    const f32x4 h0 = b0 + acc[ai][bj][m][0], h1 = b1 + acc[ai][bj][m][1];
                    if (final) { if (t >= 16) { float* op = out + (size_t)(b * SEQ + t - 16) * DM + col + 32 * bj; *(f32x4*)op = h0; *(f32x4*)(op + 4) = h1; } }
                    else {
                        ss += (h0[0] * h0[0] + h0[1] * h0[1]) + (h0[2] * h0[2] + h0[3] * h0[3]) + (h1[0] * h1[0] + h1[1] * h1[1]) + (h1[2] * h1[2] + h1[3] * h1[3]);
                        *(u32x4*)(HB + (size_t)r * DM + col + 32 * bj) = pack8(h0, h1); }
                }
                if (!final) { ss += __shfl_xor(ss, 16); ss += __shfl_xor(ss, 32); if (fq == 0) SSQ[(size_t)r * 16 + pn * 4 + wc] = ss; }
            }
        }
    }
};

struct EpiGU {
    static constexpr bool PERM = true, AFTER_DRAIN = false, IDEMP = true;
    bf16_t* ACT; const float* SSQ;
    __device__ __forceinline__ PrepRegs prep_issue(const Unit& u, int tid) const { return rs_issue(SSQ, u, tid); }
    __device__ __forceinline__ void prep_commit(LAS unsigned char* lds, const PrepRegs& r, int ui, int tid) const { rs_commit(lds, r, ui, tid); }
    __device__ __forceinline__ void run(const f32x4 (&acc)[2][2][4][2], const Unit& u, int wr, int wc, int fr, int fq, const int nai, LAS unsigned char* lds, const int ui) const {
        const LAS float* RT = (const LAS float*)(lds + LDS_RSTAB) + (ui & 1) * 256;
#pragma unroll
        for (int ai = 0; ai < nai; ++ai)
#pragma unroll
            for (int m = 0; m < 4; ++m) {
                const int r = u.pm * 256 + ai * 128 + wr * 64 + m * 16 + fr;
                const float rs = RT[ai * 128 + wr * 64 + m * 16 + fr];
                f32x4 a[2];
#pragma unroll
                for (int n = 0; n < 2; ++n) {
                    const f32x4 g = acc[ai][0][m][n] * rs, uu = acc[ai][1][m][n] * rs;
#pragma unroll
                    for (int i = 0; i < 4; ++i) a[n][i] = g[i] * uu[i] * __builtin_amdgcn_rcpf(1.0f + __expf(-g[i]));
                }
                *(u32x4*)(ACT + (size_t)r * DFF + u.pn * 128 + wc * 32 + 8 * fq) = pack8(a[0], a[1]);
            }
    }
};


constexpr int MMAIN = 32768;
template <class Epi, int K>
__device__ __forceinline__ void gemm_tail(LAS unsigned char* lds, const bf16_t* A, const bf16_t* Bt, const int N, const Epi& E, const int bid, const int G, const int tid_in) {
    int tid = tid_in; asm volatile("" : "+v"(tid));
    const int lane = tid & 63, wid = __builtin_amdgcn_readfirstlane(tid >> 6), i16 = lane & 15, kq = lane >> 4;
    constexpr int kw = K / 8, NS = kw / 32;
    const int nItems = (N >> 8) * 4;
    for (int item = bid; item < nItems; item += G) {
        const int pn = item >> 2, wc = item & 3;
        Unit ut; ut.pm = MMAIN / 256; ut.pn = pn;
        const auto prt = E.prep_issue(ut, tid);
        const bf16_t* ap = A + (size_t)(MMAIN + i16) * K + wid * kw + 8 * kq;
        const bf16_t* bp = Bt + (size_t)(256 * pn + 32 * wc + 8 * (i16 >> 2) + (i16 & 3)) * K + wid * kw + 8 * kq;
        f32x4 acc[2][4][2];
#pragma unroll
        for (int bj = 0; bj < 2; ++bj)
#pragma unroll
            for (int m = 0; m < 4; ++m)
#pragma unroll
                for (int n = 0; n < 2; ++n) acc[bj][m][n] = (f32x4){0.f, 0.f, 0.f, 0.f};
#pragma unroll
        for (int sb = 0; sb < NS; sb += 4) {
            bf16x8 af[4][4], bf[4][2][2];
#pragma unroll
            for (int s = 0; s < 4; ++s) if (sb + s < NS) {
#pragma unroll
                for (int m = 0; m < 4; ++m) af[s][m] = *(const bf16x8*)(ap + (size_t)(16 * m) * K + 32 * (sb + s));
#pragma unroll
                for (int bj = 0; bj < 2; ++bj)
#pragma unroll
                    for (int n = 0; n < 2; ++n) bf[s][bj][n] = *(const bf16x8*)(bp + (size_t)(128 * bj + 4 * n) * K + 32 * (sb + s));
            }
#pragma unroll
            for (int s = 0; s < 4; ++s) if (sb + s < NS) {
#pragma unroll
                for (int bj = 0; bj < 2; ++bj)
#pragma unroll
                    for (int m = 0; m < 4; ++m)
#pragma unroll
                        for (int n = 0; n < 2; ++n) acc[bj][m][n] = __builtin_amdgcn_mfma_f32_16x16x32_bf16(bf[s][bj][n], af[s][m], acc[bj][m][n], 0, 0, 0);
            }
        }
        E.prep_commit(lds, prt, 0, tid);
        LAS f32x4* P = (LAS f32x4*)lds;
#pragma unroll
        for (int bj = 0; bj < 2; ++bj)
#pragma unroll
            for (int m = 0; m < 4; ++m)
#pragma unroll
                for (int n = 0; n < 2; ++n) P[(wid * 16 + bj * 8 + m * 2 + n) * 64 + lane] = acc[bj][m][n];
        __syncthreads();
        if (wid == 0) {
            f32x4 full[2][2][4][2];
#pragma unroll
            for (int bj = 0; bj < 2; ++bj)
#pragma unroll
                for (int m = 0; m < 4; ++m)
#pragma unroll
                    for (int n = 0; n < 2; ++n) { full[0][bj][m][n] = acc[bj][m][n]; full[1][bj][m][n] = (f32x4){0.f, 0.f, 0.f, 0.f}; }
#pragma unroll 1
            for (int w = 1; w < 8; ++w) {
#pragma unroll
                for (int bj = 0; bj < 2; ++bj)
#pragma unroll
                    for (int m = 0; m < 4; ++m)
#pragma unroll
                        for (int n = 0; n < 2; ++n) full[0][bj][m][n] += P[(w * 16 + bj * 8 + m * 2 + n) * 64 + lane];
                asm volatile("" ::: "memory");
            }
            Unit u; u.pm = MMAIN / 256; u.pn = pn;
            E.run(full, u, 0, wc, lane & 15, lane >> 4, 1, lds, 0);
        }
        __syncthreads();
    }
}
__device__ __forceinline__ unsigned f2bf(float f) { unsigned u = __float_as_uint(f); return (u + 0x7fffu + ((u >> 16) & 1u)) >> 16; }
__device__ __forceinline__ unsigned pk2(float lo, float hi) { return f2bf(lo) | (f2bf(hi) << 16); }
__device__ __forceinline__ void transpose_item(const float* W, int K, int Nsrc, bf16_t* WT, int n0, int src_col0, int k0, const float* gk, LAS float* scr, int lane) {
    float wv[32];
#pragma unroll
    for (int i = 0; i < 32; ++i) wv[i] = W[(size_t)(k0 + 2 * i + (lane >> 5)) * Nsrc + src_col0 + (lane & 31)];
#pragma unroll
    for (int i = 0; i < 32; ++i) { const int kk = 2 * i + (lane >> 5); float v = wv[i]; if (gk) v *= gk[k0 + kk]; scr[kk * 33 + (lane & 31)] = v; }
    asm volatile("s_waitcnt lgkmcnt(0)" ::: "memory");
    const int c = lane & 7;
#pragma unroll
    for (int j = 0; j < 4; ++j) { const int n = (lane >> 3) + 8 * j; const LAS float* s = scr + (8 * c) * 33 + n;
        u32x4 o; o.x = pk2(s[0 * 33], s[1 * 33]); o.y = pk2(s[2 * 33], s[3 * 33]); o.z = pk2(s[4 * 33], s[5 * 33]); o.w = pk2(s[6 * 33], s[7 * 33]);
        *(u32x4*)(WT + (size_t)(n0 + n) * K + k0 + 8 * c) = o; }
    asm volatile("s_waitcnt lgkmcnt(0)" ::: "memory");
}
__device__ __forceinline__ int perm_src(int n0) { const int pn = n0 >> 8, rem = n0 & 255, bj = rem >> 7, wc = (rem >> 5) & 3; return pn * 256 + wc * 64 + bj * 32; }
__device__ __forceinline__ int gu_src(int n0) { const int pn = n0 >> 8, rem = n0 & 255, bj = rem >> 7, wc = (rem >> 5) & 3; return bj * DFF + pn * 128 + wc * 32; }

struct Params { const float* in[23]; float* out; unsigned char* ws; };

__device__ __forceinline__ void prologue(const Params& p, LAS unsigned char* lds, int bid, int G, int tid_in) {
    int tid = tid_in; asm volatile("" : "+v"(tid));
    const int lane = tid & 63, wave = tid >> 6;
    LAS float* scr = (LAS float*)(lds + wave * 16384);
    const int gw = bid * 8 + wave, NGW = G * 8;
    constexpr int I_IN = 16 * 80, I_O = 16 * 32, I_GU = 16 * 176, I_D = 44 * 32, I_L = I_IN + I_O + I_GU + I_D;
    for (int it = gw; it < 2 * I_L; it += NGW) {
        const int l = it / I_L; int r = it - l * I_L;
        unsigned char* wl = p.ws + WS_W + (size_t)l * W_LAYER;
        if (r < I_IN) { const int kb = r / 80, nb = r % 80; transpose_item(p.in[3] + (size_t)l * DM * NIN, DM, NIN, (bf16_t*)(wl + W_IN), 32 * nb, perm_src(32 * nb), 64 * kb, p.in[2] + l * DM, scr, lane); continue; } r -= I_IN;
        if (r < I_O) { const int kb = r / 32, nb = r % 32; transpose_item(p.in[19] + (size_t)l * DM * DM, DM, DM, (bf16_t*)(wl + W_O), 32 * nb, perm_src(32 * nb), 64 * kb, nullptr, scr, lane); continue; } r -= I_O;
        if (r < I_GU) { const int kb = r / 176, nb = r % 176; transpose_item(p.in[21] + (size_t)l * DM * 2 * DFF, DM, 2 * DFF, (bf16_t*)(wl + W_GU), 32 * nb, gu_src(32 * nb), 64 * kb, p.in[20] + l * DM, scr, lane); continue; } r -= I_GU;
        { const int kb = r / 32, nb = r % 32; transpose_item(p.in[22] + (size_t)l * DFF * DM, DFF, DM, (bf16_t*)(wl + W_D), 32 * nb, perm_src(32 * nb), 64 * kb, nullptr, scr, lane); }
    }
    bf16_t* HB = (bf16_t*)(p.ws + WS_HB); float* SSQ = (float*)(p.ws + WS_SSQ); bf16_t* MIX = (bf16_t*)(p.ws + WS_MIX);
    for (int m0 = gw; m0 < MP; m0 += 2 * NGW) {
        f32x4 v[2][4];
#pragma unroll
        for (int q = 0; q < 2; ++q) { const int m = m0 + q * NGW;
            if (m < MROWS) { int b, t; row_bt(m, b, t);
                const f32x4* xr = (const f32x4*)(t < 16 ? p.in[1] + (size_t)t * DM : p.in[0] + (size_t)(b * SEQ + t - 16) * DM) + lane;
#pragma unroll
                for (int j = 0; j < 4; ++j) v[q][j] = xr[64 * j];
            } else {
#pragma unroll
                for (int j = 0; j < 4; ++j) v[q][j] = (f32x4){0.f, 0.f, 0.f, 0.f};
            } }
#pragma unroll
        for (int q = 0; q < 2; ++q) { const int m = m0 + q * NGW; if (m >= MP) continue;
            float s = 0.f;
#pragma unroll
            for (int j = 0; j < 4; ++j) s += (v[q][j][0] * v[q][j][0] + v[q][j][1] * v[q][j][1]) + (v[q][j][2] * v[q][j][2] + v[q][j][3] * v[q][j][3]);
            if (m >= MROWS) { u32x2* mo = (u32x2*)(MIX + (size_t)m * DM) + lane;
#pragma unroll
                for (int j = 0; j < 4; ++j) mo[64 * j] = (u32x2){0u, 0u}; }
#pragma unroll
            for (int o = 1; o < 64; o <<= 1) s += __shfl_xor(s, o);
            u32x2* ho = (u32x2*)(HB + (size_t)m * DM) + lane;
#pragma unroll
            for (int j = 0; j < 4; ++j) ho[64 * j] = (u32x2){cvtpk(v[q][j][0], v[q][j][1]), cvtpk(v[q][j][2], v[q][j][3])};
            if (lane < 16) SSQ[(size_t)m * 16 + lane] = (lane == 0) ? s : 0.f; }
    }
    { bf16_t* WG = (bf16_t*)(p.ws + WS_WG);
      for (int idx = bid * 512 + tid; idx < 2 * 2 * 8 * 4096; idx += G * 512) { const int d = idx & 63, e = (idx >> 6) & 63, n = (idx >> 12) & 7, g = (idx >> 15) & 1, l = idx >> 16;
          WG[idx] = (bf16_t)f2bf(p.in[g == 0 ? 13 : 15][(size_t)((l * 8 + n) * 64 + d) * 64 + e]); } }
}

struct RecArgs { const bf16_t* PJ; bf16_t* HL; bf16_t* CA; float* SUMA; float* SUMH; bf16_t* MIX;
                 const float *conv_w, *conv_b, *b_rg, *b_ig, *lruL, *recg; const bf16_t* wgt; };
constexpr int XC_STRIDE = 1040;

__device__ __forceinline__ void rec_et(LAS unsigned char* lds, const RecArgs& a, const bf16_t* Wr, const bf16_t* Wi, const int et, const int n, const int r32, const int hi,
                                       const int b, const int c, const int t0, const int nvalid, LAS float* Pbrg, LAS float* Pbig, LAS float* Plsl) {
            float A0[16], H0[16];
#pragma unroll
            for (int r = 0; r < 16; ++r) { A0[r] = 1.0f; H0[r] = 0.f; }
            const int ntt = nvalid > 32 ? 2 : 1;
#pragma unroll 1
            for (int tt = 0; tt < ntt; ++tt) {
                f32x16 accr = {}, acci = {};
#pragma unroll
                for (int kk = 0; kk < 4; ++kk) { const bf16x8 xb = *(const LAS bf16x8*)(lds + (32 * tt + r32) * XC_STRIDE + (64 * n + 16 * kk + 8 * hi) * 2);
                    const bf16x8 war = *(const bf16x8*)(Wr + (32 * et + r32) * 64 + 16 * kk + 8 * hi), wai = *(const bf16x8*)(Wi + (32 * et + r32) * 64 + 16 * kk + 8 * hi);
                    accr = __builtin_amdgcn_mfma_f32_32x32x16_bf16(war, xb, accr, 0, 0, 0);
                    acci = __builtin_amdgcn_mfma_f32_32x32x16_bf16(wai, xb, acci, 0, 0, 0); }
                const int tok = 32 * tt + r32, t = t0 + tok; const bool valid = tok < nvalid;
                float av[16], uv[16];
#pragma unroll
                for (int r = 0; r < 16; ++r) { const int ch = 64 * n + 32 * et + (r & 3) + 8 * (r >> 2) + 4 * hi;
                    const float xcv = bf2f(*(const LAS unsigned short*)(lds + tok * XC_STRIDE + ch * 2));
                    const float rg = __builtin_amdgcn_rcpf(1.0f + __expf(-(accr[r] + Pbrg[ch]))), ig = __builtin_amdgcn_rcpf(1.0f + __expf(-(acci[r] + Pbig[ch])));
                    const float la = rg * Plsl[ch]; float aa = __expf(la); float mult = __builtin_amdgcn_sqrtf(fmaxf(__builtin_fmaf(-aa, aa, 1.0f), 0.f)); if (t == 0) mult = 1.0f;
                    float uu = mult * ig * xcv; if (!valid) { aa = 1.0f; uu = 0.f; }
                    av[r] = aa; uv[r] = uu; }
#define DPP_F(OLD, X, CTRL, RM) __builtin_amdgcn_update_dpp((OLD), (X), (CTRL), (RM), 0xf, false)
#define SCAN_STEP(CTRL, RM) do { _Pragma("unroll") for (int r = 0; r < 16; ++r) { const float ap = DPP_F(1.0f, av[r], CTRL, RM), up = DPP_F(0.0f, uv[r], CTRL, RM); uv[r] = __builtin_fmaf(av[r], up, uv[r]); av[r] = av[r] * ap; } } while (0)
                SCAN_STEP(0x111, 0xf); SCAN_STEP(0x112, 0xf); SCAN_STEP(0x114, 0xf); SCAN_STEP(0x118, 0xf);
                SCAN_STEP(0x142, 0xa);
#undef SCAN_STEP
#undef DPP_F
                if (tt == 0) {
#pragma unroll
                    for (int r = 0; r < 16; ++r) { A0[r] = __shfl(av[r], 31, 32); H0[r] = __shfl(uv[r], 31, 32); }
                } else {
#pragma unroll
                    for (int r = 0; r < 16; ++r) { uv[r] = av[r] * H0[r] + uv[r]; av[r] = av[r] * A0[r]; }
                }
                if (valid) {
#pragma unroll
                    for (int g4 = 0; g4 < 4; ++g4) { const int ch0 = 64 * n + 32 * et + 8 * g4 + 4 * hi; const size_t off = (size_t)(b * TT + t) * 512 + ch0;
                        *(u32x2*)(a.HL + off) = (u32x2){cvtpk(uv[4 * g4], uv[4 * g4 + 1]), cvtpk(uv[4 * g4 + 2], uv[4 * g4 + 3])};
                        *(u32x2*)(a.CA + off) = (u32x2){cvtpk(av[4 * g4], av[4 * g4 + 1]), cvtpk(av[4 * g4 + 2], av[4 * g4 + 3])}; }
                }
                if (tt == ntt - 1 && r32 == 31) {
#pragma unroll
                    for (int g4 = 0; g4 < 4; ++g4) { const int ch0 = 64 * n + 32 * et + 8 * g4 + 4 * hi; const size_t off = (size_t)(b * NCH + c) * 512 + ch0;
                        *(f32x4*)(a.SUMA + off) = (f32x4){av[4 * g4], av[4 * g4 + 1], av[4 * g4 + 2], av[4 * g4 + 3]};
                        *(f32x4*)(a.SUMH + off) = (f32x4){uv[4 * g4], uv[4 * g4 + 1], uv[4 * g4 + 2], uv[4 * g4 + 3]}; }
                }
            }
        }

__device__ __forceinline__ void rec_local_phase(LAS unsigned char* lds, const RecArgs& a, int bid, int G, int tid_in) {
    int tid = tid_in; asm volatile("" : "+v"(tid));
    const int lane = tid & 63, wid = __builtin_amdgcn_readfirstlane(tid >> 6), r32 = lane & 31, hi = lane >> 5;
    LAS float* Pbrg = (LAS float*)(lds + 66560); LAS float* Pbig = Pbrg + 512; LAS float* Plsl = Pbig + 512;
    Pbrg[tid] = a.b_rg[tid]; Pbig[tid] = a.b_ig[tid]; { const float L = a.lruL[tid]; Plsl[tid] = -8.0f * log1pf(__expf(-L)); }
    const bf16_t* Wr = a.wgt + (size_t)wid * 4096; const bf16_t* Wi = Wr + 8 * 4096;
    __syncthreads();
    for (int item = bid; item < NBATCH * NCH; item += G) {
        const int b = item < 512 ? (item >> 7) : (item - 512), c = item < 512 ? (item & 127) : 128, t0 = 64 * c, nvalid = (TT - t0) < 64 ? (TT - t0) : 64;
        if (8 * wid < nvalid) {
            float cw[4][8], cb[8];
#pragma unroll
            for (int k = 0; k < 4; ++k) { const f32x4 w0 = *(const f32x4*)(a.conv_w + k * 512 + 8 * lane), w1 = *(const f32x4*)(a.conv_w + k * 512 + 8 * lane + 4);
#pragma unroll
                for (int j = 0; j < 4; ++j) { cw[k][j] = w0[j]; cw[k][4 + j] = w1[j]; } }
            { const f32x4 w0 = *(const f32x4*)(a.conv_b + 8 * lane), w1 = *(const f32x4*)(a.conv_b + 8 * lane + 4);
#pragma unroll
                for (int j = 0; j < 4; ++j) { cb[j] = w0[j]; cb[4 + j] = w1[j]; } }
            u32x4 raws[11];
#pragma unroll
            for (int k = 0; k < 11; ++k) { const int t = t0 + 8 * wid - 3 + k; raws[k] = (u32x4){0u, 0u, 0u, 0u};
                if (t >= 0 && t < TT) raws[k] = *(const u32x4*)(a.PJ + (size_t)(b * TT + t) * NIN + 1536 + 8 * lane); }
            float win[3][8];
#pragma unroll
            for (int k = 0; k < 3; ++k) {
#pragma unroll
                for (int j = 0; j < 4; ++j) { win[k][2 * j] = __uint_as_float(raws[k][j] << 16); win[k][2 * j + 1] = __uint_as_float(raws[k][j] & 0xffff0000u); } }
#pragma unroll
            for (int i = 0; i < 8; ++i) { const u32x4 raw = raws[3 + i];
                float cur[8], o[8];
#pragma unroll
                for (int j = 0; j < 4; ++j) { cur[2 * j] = __uint_as_float(raw[j] << 16); cur[2 * j + 1] = __uint_as_float(raw[j] & 0xffff0000u); }
#pragma unroll
                for (int j = 0; j < 8; ++j) { o[j] = cb[j] + cw[0][j] * win[0][j] + cw[1][j] * win[1][j] + cw[2][j] * win[2][j] + cw[3][j] * cur[j]; win[0][j] = win[1][j]; win[1][j] = win[2][j]; win[2][j] = cur[j]; }
                u32x4 w; w.x = cvtpk(o[0], o[1]); w.y = cvtpk(o[2], o[3]); w.z = cvtpk(o[4], o[5]); w.w = cvtpk(o[6], o[7]);
                *(LAS u32x4*)(lds + (8 * wid + i) * XC_STRIDE + lane * 16) = w; }
        }
        __syncthreads();
        const int n = wid;
        rec_et(lds, a, Wr, Wi, 0, n, r32, hi, b, c, t0, nvalid, Pbrg, Pbig, Plsl);
        rec_et(lds, a, Wr, Wi, 1, n, r32, hi, b, c, t0, nvalid, Pbrg, Pbig, Plsl);
        __syncthreads();
    }
}

__device__ __forceinline__ float gelu_tanh(float x) {
    const float u = 0.7978845608028654f * (x + 0.044715f * x * x * x);
    const float e = __expf(2.0f * u);
    const float th = 1.0f - 2.0f * __builtin_amdgcn_rcpf(e + 1.0f);
    return 0.5f * x * (1.0f + th);
}
__device__ __forceinline__ void rec_fix_phase(LAS unsigned char* lds, const RecArgs& a, int bid, int G, int tid_in) {
    int tid = tid_in; asm volatile("" : "+v"(tid));
    const int lane = tid & 63, wid = __builtin_amdgcn_readfirstlane(tid >> 6);
    LAS float* Lc = (LAS float*)lds;
    for (int item = bid; item < NBATCH * NCH; item += G) {
        const int b = item < 512 ? (item >> 7) : (item - 512), c = item < 512 ? (item & 127) : 128, t0 = 64 * c, nvalid = (TT - t0) < 64 ? (TT - t0) : 64;
        u32x4 hls[8], cas[8], gts[8];
        if (8 * wid < nvalid) {
#pragma unroll
            for (int i = 0; i < 8; ++i) { const size_t m = (size_t)(b * TT + t0 + 8 * wid + i);
                hls[i] = *(const u32x4*)(a.HL + m * 512 + 8 * lane); cas[i] = *(const u32x4*)(a.CA + m * 512 + 8 * lane); gts[i] = *(const u32x4*)(a.PJ + m * NIN + 2048 + 8 * lane); }
        }
        float carry = 0.f;
        {
            const float* pa = a.SUMA + (size_t)(b * NCH) * 512 + tid; const float* ph = a.SUMH + (size_t)(b * NCH) * 512 + tid;
            int cc = 0;
            for (; cc + 32 <= c; cc += 32) { float A_[32], H_[32];
#pragma unroll
                for (int i = 0; i < 32; ++i) { A_[i] = pa[(size_t)(cc + i) * 512]; H_[i] = ph[(size_t)(cc + i) * 512]; }
#pragma unroll
                for (int i = 0; i < 32; ++i) carry = A_[i] * carry + H_[i]; }
            for (; cc + 8 <= c; cc += 8) { float A_[8], H_[8];
#pragma unroll
                for (int i = 0; i < 8; ++i) { A_[i] = pa[(size_t)(cc + i) * 512]; H_[i] = ph[(size_t)(cc + i) * 512]; }
#pragma unroll
                for (int i = 0; i < 8; ++i) carry = A_[i] * carry + H_[i]; }
            for (; cc < c; ++cc) carry = pa[(size_t)cc * 512] * carry + ph[(size_t)cc * 512];
        }
        Lc[tid] = carry;
        __syncthreads();
        float cv[8], gg[8];
        { const f32x4 c0 = *(const LAS f32x4*)(Lc + 8 * lane), c1 = *(const LAS f32x4*)(Lc + 8 * lane + 4);
          const f32x4 g0 = *(const f32x4*)(a.recg + 8 * lane), g1 = *(const f32x4*)(a.recg + 8 * lane + 4);
#pragma unroll
          for (int j = 0; j < 4; ++j) { cv[j] = c0[j]; cv[4 + j] = c1[j]; gg[j] = g0[j]; gg[4 + j] = g1[j]; } }
        if (8 * wid < nvalid) {
#pragma unroll
        for (int i = 0; i < 8; ++i) { const int tok = 8 * wid + i;
            const size_t m = (size_t)(b * TT + t0 + tok);
            const u32x4 hl = hls[i], ca = cas[i], gt = gts[i];
            float y[8]; float ss = 0.f;
#pragma unroll
            for (int j = 0; j < 4; ++j) {
                const float h0 = __uint_as_float(hl[j] << 16) + __uint_as_float(ca[j] << 16) * cv[2 * j], h1 = __uint_as_float(hl[j] & 0xffff0000u) + __uint_as_float(ca[j] & 0xffff0000u) * cv[2 * j + 1];
                y[2 * j] = h0 * gelu_tanh(__uint_as_float(gt[j] << 16)); y[2 * j + 1] = h1 * gelu_tanh(__uint_as_float(gt[j] & 0xffff0000u));
                ss += y[2 * j] * y[2 * j] + y[2 * j + 1] * y[2 * j + 1]; }
#pragma unroll
            for (int o = 1; o < 64; o <<= 1) ss += __shfl_xor(ss, o);
            const float rn = rsqrtf(ss * (1.0f / 512.0f) + EPS);
            u32x4 w; w.x = cvtpk(y[0] * rn * gg[0], y[1] * rn * gg[1]); w.y = cvtpk(y[2] * rn * gg[2], y[3] * rn * gg[3]);
            w.z = cvtpk(y[4] * rn * gg[4], y[5] * rn * gg[5]); w.w = cvtpk(y[6] * rn * gg[6], y[7] * rn * gg[7]);
            *(u32x4*)(a.MIX + m * DM + 512 + 8 * lane) = w; }
        }
        __syncthreads();
    }
}

struct AttnArgs { const bf16_t* PJ; bf16_t* MIX; const float* subg; unsigned* ctr; float lam, shift, osc; };
constexpr int KSTR = 272, VSTR = 320, KBUF = 64 * KSTR, VBUF = 64 * VSTR, A_K0 = 0, A_V0 = 2 * KBUF, A_RING = 2 * KBUF + 3 * VBUF, SSTR = 132;
constexpr int NUNITS = 16 * NQB;

__device__ __forceinline__ void attn_phase(LAS unsigned char* lds, const AttnArgs& a, int tid_in) {
    int tid = tid_in; asm volatile("" : "+v"(tid));
    const int lane = tid & 63, wid = __builtin_amdgcn_readfirstlane(tid >> 6), r32 = lane & 31, hi = lane >> 5, rg = wid & 3, c = wid >> 2;
    LAS unsigned* sU = (LAS unsigned*)(lds + LDS_MISC);
    LAS float* LW = (LAS float*)(lds + LDS_MISC + 256) + wid * 32;
    const int skey = tid >> 4, sch = tid & 15;
    const int q4 = (lane & 15) >> 2, p4 = lane & 3, ch2 = (lane >> 4) & 1;
    const unsigned xcc = xb_xcc_id() & 7u;
    unsigned dead = 0u;
#define A_FETCH(res) do { res = 0xffffffffu; \
            for (unsigned i_ = 0; i_ < 8u && res == 0xffffffffu; ++i_) { const unsigned j_ = (xcc + i_) & 7u; \
                if (dead & (1u << j_)) continue; \
                const unsigned k_ = atomicAdd(a.ctr + 32 * j_, 1u); \
                if (k_ < 2u * NQB) res = (j_ << 8) | k_; else dead |= 1u << j_; } } while (0)
#define A_LOAD(t) do { _Pragma("unroll") for (int j_ = 0; j_ < 2; ++j_) { kreg[j_] = *(const u32x4*)(kg + (size_t)(64 * (t) + 32 * j_) * NIN); vreg[j_] = *(const u32x4*)(kg + 512 + (size_t)(64 * (t) + 32 * j_) * NIN); } } while (0)
#define A_STORE(kbi, vbi) do { _Pragma("unroll") for (int j_ = 0; j_ < 2; ++j_) { *(LAS u32x4*)(lds + A_K0 + (kbi) * KBUF + (skey + 32 * j_) * KSTR + sch * 16) = kreg[j_]; *(LAS u32x4*)(lds + A_V0 + (vbi) * VBUF + (skey + 32 * j_) * VSTR + sch * 16) = vreg[j_]; } } while (0)
#define A_UNIT_PRELOAD(U, QB, B_, H_, NT_, ROWB) do { const int qj_ = (int)((U) >> 8), qk_ = (int)((U) & 255u); \
            QB = (NQB - 1) - (qk_ >> 1); const int bh_ = 2 * qj_ + (qk_ & 1); B_ = bh_ >> 2; H_ = bh_ & 3; \
            NT_ = (2 * QB + 2) < NCH ? (2 * QB + 2) : NCH; ROWB = (size_t)B_ * TT; \
            { const bf16_t* qp_ = a.PJ + ((ROWB + 128 * QB) * NIN + H_ * 128) + qoff; \
              _Pragma("unroll") for (int d0 = 0; d0 < 4; ++d0) qr[d0] = *(const bf16x8*)(qp_ + 16 * d0); } \
            kg = a.PJ + (ROWB * NIN + 512 + H_ * 128) + koff; \
            A_LOAD(0); } while (0)
    const unsigned qoff = (unsigned)((32 * rg + r32) * NIN + c * 64 + 8 * hi), koff = (unsigned)(skey * NIN + sch * 8);
    bf16x8 qr[4]; const bf16_t* kg; u32x4 kreg[2], vreg[2];
    int qb, b, h, NT; size_t rowb;
    {
        if (tid == 0) { unsigned res; A_FETCH(res); *sU = res; }
        __syncthreads();
        const unsigned u0 = *sU;
        __syncthreads();
        if (u0 == 0xffffffffu) return;
        A_UNIT_PRELOAD(u0, qb, b, h, NT, rowb);
    }
    for (;;) {
        A_STORE(0, 0);
        __syncthreads();
        f32x16 o[4]; o[0] = f32x16{}; o[1] = f32x16{}; o[2] = f32x16{}; o[3] = f32x16{};
        float lsum = 0.f;
        const int qpos = 128 * qb + 32 * rg + r32;
#define SB() __builtin_amdgcn_sched_barrier(0)
#define MF(A, B, C) __builtin_amdgcn_mfma_f32_32x32x16_bf16(A, B, C, 0, 0, 0)
#define VREAD(buf, sl) do { _Pragma("unroll") for (int db_ = 0; db_ < 4; ++db_) { \
            const s16x4 lo_ = __builtin_bit_cast(s16x4, __builtin_amdgcn_ds_read_tr16_b64_v4i16((LAS s16x4*)(vb + 16 * (sl) * VSTR + db_ * 64))); \
            const s16x4 hh_ = __builtin_bit_cast(s16x4, __builtin_amdgcn_ds_read_tr16_b64_v4i16((LAS s16x4*)(vb + (16 * (sl) + 8) * VSTR + db_ * 64))); \
            buf[db_] = (bf16x8){lo_[0], lo_[1], lo_[2], lo_[3], hh_[0], hh_[1], hh_[2], hh_[3]}; } } while (0)
#define EX4(P, B) do { P[B] = __builtin_amdgcn_exp2f(P[B]); P[B + 1] = __builtin_amdgcn_exp2f(P[B + 1]); P[B + 2] = __builtin_amdgcn_exp2f(P[B + 2]); P[B + 3] = __builtin_amdgcn_exp2f(P[B + 3]); } while (0)
#define PK4(W, P, B) do { W[0] = cvtpk(P[B], P[B + 1]); W[1] = cvtpk(P[B + 2], P[B + 3]); W[2] = cvtpk(P[B + 4], P[B + 5]); W[3] = cvtpk(P[B + 6], P[B + 7]); } while (0)
#define SUM8(P, B) do { lsum += ((P[B] + P[B + 1]) + (P[B + 2] + P[B + 3])) + ((P[B + 4] + P[B + 5]) + (P[B + 6] + P[B + 7])); } while (0)
#define AS_BF(W) __builtin_bit_cast(bf16x8, W)
#define A_QK(t) \
            const LAS unsigned char* kb = lds + A_K0 + ((t) & 1) * KBUF + r32 * KSTR + (c * 64 + 8 * hi) * 2; \
            bf16x8 kf[8]; \
            _Pragma("unroll") for (int d0 = 0; d0 < 4; ++d0) { kf[2 * d0] = *(const LAS bf16x8*)(kb + d0 * 32); kf[2 * d0 + 1] = *(const LAS bf16x8*)(kb + 32 * KSTR + d0 * 32); } \
            f32x16 p0, p1; \
            p0 = MF(kf[0], qr[0], cinit); p1 = MF(kf[1], qr[0], cinit); \
            _Pragma("unroll") for (int d0 = 1; d0 < 4; ++d0) { p0 = MF(kf[2 * d0], qr[d0], p0); p1 = MF(kf[2 * d0 + 1], qr[d0], p1); }
#define A_MASK(P, t, OFF) do { _Pragma("unroll") for (int r = 0; r < 16; ++r) { const int kp = 64 * (t) + (OFF) + (r & 3) + 8 * (r >> 2) + 4 * hi; if (kp > qpos) P[r] = 0.f; } } while (0)
#define A_FIRST(MASKED, t) do { A_QK(t) \
            EX4(p0, 0); EX4(p0, 4); EX4(p0, 8); EX4(p0, 12); EX4(p1, 0); EX4(p1, 4); EX4(p1, 8); EX4(p1, 12); \
            if (MASKED) { A_MASK(p0, t, 0); A_MASK(p1, t, 32); } \
            SUM8(p0, 0); SUM8(p0, 8); SUM8(p1, 0); SUM8(p1, 8); \
            PK4(pwp0, p0, 0); PK4(pwp1, p0, 8); PK4(pwp2, p1, 0); PK4(pwp3, p1, 8); } while (0)
#define VRD1(dst, sl, db) do { \
            const s16x4 lo_ = __builtin_bit_cast(s16x4, __builtin_amdgcn_ds_read_tr16_b64_v4i16((LAS s16x4*)(vb + 16 * (sl) * VSTR + (db) * 64))); \
            const s16x4 hh_ = __builtin_bit_cast(s16x4, __builtin_amdgcn_ds_read_tr16_b64_v4i16((LAS s16x4*)(vb + (16 * (sl) + 8) * VSTR + (db) * 64))); \
            dst = (bf16x8){lo_[0], lo_[1], lo_[2], lo_[3], hh_[0], hh_[1], hh_[2], hh_[3]}; } while (0)
#define A_PIPE(MASKED, t, vslot) do { A_QK(t) \
            const LAS unsigned char* vb = lds + A_V0 + (vslot) * VBUF + (4 * hi + q4) * VSTR + (16 * ch2 + 4 * p4) * 2; \
            bf16x8 vf[4]; \
            VREAD(vf, 0); SB(); \
            __builtin_amdgcn_s_setprio(1); \
            o[0] = MF(AS_BF(pwp0), vf[0], o[0]); VRD1(vf[0], 1, 0); EX4(p0, 0); SB(); \
            o[1] = MF(AS_BF(pwp0), vf[1], o[1]); VRD1(vf[1], 1, 1); EX4(p0, 4); SB(); \
            o[2] = MF(AS_BF(pwp0), vf[2], o[2]); VRD1(vf[2], 1, 2); EX4(p0, 8); SB(); \
            o[3] = MF(AS_BF(pwp0), vf[3], o[3]); VRD1(vf[3], 1, 3); EX4(p0, 12); if (MASKED) A_MASK(p0, t, 0); SB(); \
            o[0] = MF(AS_BF(pwp1), vf[0], o[0]); VRD1(vf[0], 2, 0); EX4(p1, 0); SB(); \
            o[1] = MF(AS_BF(pwp1), vf[1], o[1]); VRD1(vf[1], 2, 1); EX4(p1, 4); SB(); \
            o[2] = MF(AS_BF(pwp1), vf[2], o[2]); VRD1(vf[2], 2, 2); EX4(p1, 8); SB(); \
            o[3] = MF(AS_BF(pwp1), vf[3], o[3]); VRD1(vf[3], 2, 3); EX4(p1, 12); if (MASKED) A_MASK(p1, t, 32); SB(); \
            o[0] = MF(AS_BF(pwp2), vf[0], o[0]); VRD1(vf[0], 3, 0); PK4(pwp0, p0, 0); SB(); \
            o[1] = MF(AS_BF(pwp2), vf[1], o[1]); VRD1(vf[1], 3, 1); PK4(pwp1, p0, 8); SB(); \
            o[2] = MF(AS_BF(pwp2), vf[2], o[2]); VRD1(vf[2], 3, 2); SB(); \
            o[3] = MF(AS_BF(pwp2), vf[3], o[3]); VRD1(vf[3], 3, 3); SB(); \
            o[0] = MF(AS_BF(pwp3), vf[0], o[0]); o[1] = MF(AS_BF(pwp3), vf[1], o[1]); o[2] = MF(AS_BF(pwp3), vf[2], o[2]); o[3] = MF(AS_BF(pwp3), vf[3], o[3]); \
            __builtin_amdgcn_s_setprio(0); \
            PK4(pwp2, p1, 0); PK4(pwp3, p1, 8); \
            SUM8(p0, 0); SUM8(p0, 8); SUM8(p1, 0); SUM8(p1, 8); } while (0)
#define A_DRAIN(vslot) do { \
            const LAS unsigned char* vb = lds + A_V0 + (vslot) * VBUF + (4 * hi + q4) * VSTR + (16 * ch2 + 4 * p4) * 2; \
            bf16x8 vf[4]; \
            VREAD(vf, 0); \
            o[0] = MF(AS_BF(pwp0), vf[0], o[0]); VRD1(vf[0], 1, 0); o[1] = MF(AS_BF(pwp0), vf[1], o[1]); VRD1(vf[1], 1, 1); o[2] = MF(AS_BF(pwp0), vf[2], o[2]); VRD1(vf[2], 1, 2); o[3] = MF(AS_BF(pwp0), vf[3], o[3]); VRD1(vf[3], 1, 3); SB(); \
            o[0] = MF(AS_BF(pwp1), vf[0], o[0]); VRD1(vf[0], 2, 0); o[1] = MF(AS_BF(pwp1), vf[1], o[1]); VRD1(vf[1], 2, 1); o[2] = MF(AS_BF(pwp1), vf[2], o[2]); VRD1(vf[2], 2, 2); o[3] = MF(AS_BF(pwp1), vf[3], o[3]); VRD1(vf[3], 2, 3); SB(); \
            o[0] = MF(AS_BF(pwp2), vf[0], o[0]); VRD1(vf[0], 3, 0); o[1] = MF(AS_BF(pwp2), vf[1], o[1]); VRD1(vf[1], 3, 1); o[2] = MF(AS_BF(pwp2), vf[2], o[2]); VRD1(vf[2], 3, 2); o[3] = MF(AS_BF(pwp2), vf[3], o[3]); VRD1(vf[3], 3, 3); SB(); \
            o[0] = MF(AS_BF(pwp3), vf[0], o[0]); o[1] = MF(AS_BF(pwp3), vf[1], o[1]); o[2] = MF(AS_BF(pwp3), vf[2], o[2]); o[3] = MF(AS_BF(pwp3), vf[3], o[3]); } while (0)
        f32x16 cinit;
#pragma unroll
        for (int r = 0; r < 16; ++r) cinit[r] = -a.shift;
        asm volatile("" : "+v"(cinit));
        asm volatile("" : "+v"(qr[0]), "+v"(qr[1]), "+v"(qr[2]), "+v"(qr[3]));
        const int NTM = (2 * qb) < NT ? (2 * qb) : NT;
        u32x4 pwp0, pwp1, pwp2, pwp3;
        A_LOAD(1);
        if (NTM == 0) A_FIRST(true, 0); else A_FIRST(false, 0);
        A_STORE(1, 1);
        __syncthreads();
        int t = 1, vp = 0, vn = 2;
        for (; t < NTM; ++t) {
            A_LOAD(t + 1);
            A_PIPE(false, t, vp);
            A_STORE((t + 1) & 1, vn);
            __syncthreads();
            vp = (vp == 2) ? 0 : vp + 1; vn = (vn == 2) ? 0 : vn + 1;
        }
        for (; t < NT; ++t) {
            if (t + 1 < NT) A_LOAD(t + 1);
            A_PIPE(true, t, vp);
            if (t + 1 < NT) A_STORE((t + 1) & 1, vn);
            __syncthreads();
            vp = (vp == 2) ? 0 : vp + 1; vn = (vn == 2) ? 0 : vn + 1;
        }
        A_DRAIN(vp);
        __syncthreads();
#undef A_QK
#undef A_MASK
#undef A_FIRST
#undef A_PIPE
#undef A_DRAIN
#undef VRD1
#undef SB
#undef MF
#undef VREAD
#undef EX4
#undef PK4
#undef SUM8
#undef AS_BF
        lsum += __shfl_xor(lsum, 32);
        if (hi == 0) LW[r32] = lsum;
        asm volatile("s_waitcnt lgkmcnt(0)" ::: "memory");
        LAS float* S = (LAS float*)lds;
        float li[16];
#pragma unroll
        for (int r = 0; r < 16; ++r) li[r] = (c == 0 ? 1.0f : a.lam) / LW[(r & 3) + 8 * (r >> 2) + 4 * hi];
        if (tid == 0) { unsigned res; A_FETCH(res); *sU = res; }
        if (c == 1) {
#pragma unroll
            for (int db = 0; db < 4; ++db)
#pragma unroll
                for (int r = 0; r < 16; ++r) S[(32 * rg + (r & 3) + 8 * (r >> 2) + 4 * hi) * SSTR + 32 * db + r32] = o[db][r] * li[r];
        }
        __syncthreads();
        const unsigned un = *sU;
        int nqb = 0, nb = 0, nh = 0, nNT = 0; size_t nrowb = 0;
        if (un != 0xffffffffu) A_UNIT_PRELOAD(un, nqb, nb, nh, nNT, nrowb);
        if (c == 0) {
#pragma unroll
            for (int db = 0; db < 4; ++db)
#pragma unroll
                for (int r = 0; r < 16; ++r) { LAS float* sp = S + (32 * rg + (r & 3) + 8 * (r >> 2) + 4 * hi) * SSTR + 32 * db + r32; *sp = o[db][r] * li[r] - *sp; }
        }
        __syncthreads();
        {
            const int row = 16 * wid + (lane >> 2), qd = lane & 3, tq = 128 * qb + row;
            f32x4 v[8]; float ss = 0.f;
#pragma unroll
            for (int j = 0; j < 8; ++j) { v[j] = *(const LAS f32x4*)(S + row * SSTR + 32 * qd + 4 * j); ss += (v[j][0] * v[j][0] + v[j][1] * v[j][1]) + (v[j][2] * v[j][2] + v[j][3] * v[j][3]); }
            ss += __shfl_xor(ss, 1); ss += __shfl_xor(ss, 2);
            const float rn = rsqrtf(ss * (1.0f / 128.0f) + EPS) * a.osc;
            if (tq < TT) {
                bf16_t* op = a.MIX + (rowb + tq) * DM + h * 128 + 32 * qd;
#pragma unroll
                for (int j = 0; j < 4; ++j) { const f32x4 g0 = *(const f32x4*)(a.subg + 32 * qd + 8 * j), g1 = *(const f32x4*)(a.subg + 32 * qd + 8 * j + 4);
                    *(u32x4*)(op + 8 * j) = pack8(v[2 * j] * rn * g0, v[2 * j + 1] * rn * g1); }
            }
        }
        __syncthreads();
        if (un == 0xffffffffu) break;
        qb = nqb; b = nb; h = nh; NT = nNT; rowb = nrowb;
    }
#undef A_FETCH
#undef A_UNIT_PRELOAD
#undef A_LOAD
#undef A_STORE
}

__global__ void __launch_bounds__(512) hymba_fwd(Params p) {
    extern __shared__ __attribute__((aligned(16))) unsigned char lds_raw[];
    LAS unsigned char* lds = (LAS unsigned char*)lds_raw;
    cg::grid_group grid = cg::this_grid();
    const int tid = threadIdx.x, bid = blockIdx.x, G = gridDim.x;
    if (tid < 4) ((LAS unsigned*)(lds + LDS_MISC + 64))[tid] = 0u;
    __syncthreads();
    const XcdBarrier xbar = xcd_barrier_post((unsigned*)(p.ws + WS_CTL) + 1024, (volatile LAS unsigned*)(lds + LDS_MISC + 64));
    unsigned char* ws = p.ws;
    bf16_t* HB = (bf16_t*)(ws + WS_HB); bf16_t* PJ = (bf16_t*)(ws + WS_PJ); bf16_t* MIX = (bf16_t*)(ws + WS_MIX); bf16_t* ACT = (bf16_t*)(ws + WS_ACT);
    float* SSQ = (float*)(ws + WS_SSQ);

#ifndef NO_PRO
    prologue(p, lds, bid, G, tid);
#endif
#ifdef PROBE_SYNC10
    for (int i_ = 0; i_ < 10; ++i_) grid.sync();
#endif
#ifdef PROBE_PRO2
    __syncthreads(); prologue(p, lds, bid, G, tid);
#endif
    grid.sync();

    for (int l = 0; l < 2; ++l) {
        unsigned char* wl = ws + WS_W + (size_t)l * W_LAYER;
        {
            pg8::Gemm g{HB, (const bf16_t*)(wl + W_IN), MMAIN, NIN, DM}; pg8::StaticOrder S; S.init(MMAIN, NIN, G, bid);
            EpiIn E{PJ, SSQ, p.in[4] + l * 64, p.in[5] + l * 64};
#ifndef NO_G1
            pg8::gemm_phase<EpiIn, pg8::StaticOrder, true, true>(lds, g, S, E);
#endif
            gemm_tail<EpiIn, DM>(lds, g.A, g.Bt, g.N, E, bid, G, tid);
#ifdef PROBE_G1X2
            pg8::gemm_phase<EpiIn, pg8::StaticOrder, true, true>(lds, g, S, E);
#endif
        }
        xcd_barrier(xbar);
        RecArgs ra{PJ, (bf16_t*)(ws + WS_HL), (bf16_t*)(ws + WS_CA), (float*)(ws + WS_SUMA), (float*)(ws + WS_SUMH), MIX,
                   p.in[11] + l * 4 * 512, p.in[12] + l * 512, p.in[14] + l * 512, p.in[16] + l * 512, p.in[17] + l * 512, p.in[18] + l * 512, (const bf16_t*)(ws + WS_WG) + (size_t)l * 2 * 8 * 4096};
#ifndef NO_RECL
        rec_local_phase(lds, ra, bid, G, tid);
#endif
#ifdef PROBE_RECL2
        rec_local_phase(lds, ra, bid, G, tid);
#endif
        xcd_barrier(xbar);
#ifndef NO_RECF
        rec_fix_phase(lds, ra, bid, G, tid);
#endif
#ifdef PROBE_RECF2
        rec_fix_phase(lds, ra, bid, G, tid);
#endif
        {
            const float lam_init = (l == 0) ? 0.2f : 0.35550906759096934f;
            float d1 = 0.f, d2 = 0.f, mq = 0.f, mk = 0.f;
            for (int j = 0; j < 64; ++j) { d1 += p.in[6][l * 64 + j] * p.in[7][l * 64 + j]; d2 += p.in[8][l * 64 + j] * p.in[9][l * 64 + j];
                mq = fmaxf(mq, fabsf(p.in[4][l * 64 + j])); mk = fmaxf(mk, fabsf(p.in[5][l * 64 + j])); }
            AttnArgs aa{PJ, MIX, p.in[10] + l * 128, (unsigned*)(ws + WS_CTL) + 512 * l, __expf(d1) - __expf(d2) + lam_init, 8.0f * 1.4426950408889634f * mq * mk, 1.0f - lam_init};
#ifndef NO_ATTN
            attn_phase(lds, aa, tid);
#endif
#ifdef PROBE_ATTN2
            { AttnArgs ab = aa; ab.ctr = (unsigned*)(ws + WS_CTL) + 512 * l + 256; attn_phase(lds, ab, tid); }
#endif
        }
        xcd_barrier(xbar);
        {
            pg8::Gemm g{MIX, (const bf16_t*)(wl + W_O), MMAIN, DM, DM}; pg8::StaticOrder S; S.init(MMAIN, DM, G, bid);
            EpiRes E{p.out, HB, SSQ, 0};
#ifndef NO_G3
            pg8::gemm_phase<EpiRes, pg8::StaticOrder, true, true>(lds, g, S, E);
#endif
            gemm_tail<EpiRes, DM>(lds, g.A, g.Bt, g.N, E, bid, G, tid);
        }
        xcd_barrier(xbar);
        {
            pg8::Gemm g{HB, (const bf16_t*)(wl + W_GU), MMAIN, 2 * DFF, DM}; pg8::StaticOrder S; S.init(MMAIN, 2 * DFF, G, bid);
            EpiGU E{ACT, SSQ};
#ifndef NO_G4
            pg8::gemm_phase<EpiGU, pg8::StaticOrder, true, true>(lds, g, S, E);
#endif
            gemm_tail<EpiGU, DM>(lds, g.A, g.Bt, g.N, E, bid, G, tid);
#ifdef PROBE_G4X2
            pg8::gemm_phase<EpiGU, pg8::StaticOrder, true, true>(lds, g, S, E);
#endif
        }
        xcd_barrier(xbar);
        {
            pg8::Gemm g{ACT, (const bf16_t*)(wl + W_D), MMAIN, DM, DFF}; pg8::StaticOrder S; S.init(MMAIN, DM, G, bid);
            EpiRes E{p.out, HB, SSQ, l == 1 ? 1 : 0};
#ifndef NO_G5
            pg8::gemm_phase<EpiRes, pg8::StaticOrder, true, true>(lds, g, S, E);
#endif
            gemm_tail<EpiRes, DFF>(lds, g.A, g.Bt, g.N, E, bid, G, tid);
        }
        if (l == 0) xcd_barrier(xbar);
    }
}

extern "C" void kernel_launch(void* const* d_in, const int* in_sizes, int n_in, void* d_out, int out_size, void* d_ws, size_t ws_size, hipStream_t stream) {
    static int grid = 0;
    if (grid == 0) {
        if (n_in != 23 || ws_size < WS_END) { fprintf(stderr, "kernel_launch: unexpected inputs (n_in %d, ws %zu)\n", n_in, ws_size); grid = -1; return; }
        int dev = 0, cus = 0, per_cu = 0;
        hipGetDevice(&dev); hipDeviceGetAttribute(&cus, hipDeviceAttributeMultiprocessorCount, dev);
        if (hipFuncSetAttribute((const void*)hymba_fwd, hipFuncAttributeMaxDynamicSharedMemorySize, LDS_BYTES) != hipSuccess) { fprintf(stderr, "kernel_launch: hipFuncSetAttribute failed\n"); grid = -1; return; }
        if (hipOccupancyMaxActiveBlocksPerMultiprocessor(&per_cu, (const void*)hymba_fwd, 512, LDS_BYTES) != hipSuccess || per_cu < 1) { fprintf(stderr, "kernel_launch: occupancy query says %d\n", per_cu); per_cu = 1; }
        (void)hipGetLastError();
        grid = cus;
        if (grid > 256) grid = 256;
    }
    if (grid < 0) return;
    hipMemsetAsync((char*)d_ws + WS_CTL, 0, CTL_BYTES, stream);
    Params p{};
    for (int i = 0; i < 23; ++i) p.in[i] = (const float*)d_in[i];
    p.out = (float*)d_out; p.ws = (unsigned char*)d_ws;
    void* args[] = {&p};
    hipError_t e = hipLaunchCooperativeKernel((const void*)hymba_fwd, dim3(grid), dim3(512), args, LDS_BYTES, stream);
    if (e != hipSuccess) fprintf(stderr, "kernel_launch: cooperative launch failed: %s (grid %d)\n", hipGetErrorString(e), grid);
}
```

```cpp
#include <hip/hip_runtime.h>
#include <hip/hip_cooperative_groups.h>
#include <cstdio>
#include <cstdint>
#include <cmath>
namespace cg = cooperative_groups;
namespace pg8 {
#define PG8_LAS __attribute__((address_space(3)))
typedef unsigned short bf16_t;
typedef short bf16x8 __attribute__((ext_vector_type(8)));
typedef float f32x4 __attribute__((ext_vector_type(4)));
typedef unsigned u32x4 __attribute__((ext_vector_type(4)));
constexpr int BM = 256, BK = 64, HALF = 128, HTB = HALF * BK * 2  , STAGE_BYTES = 8 * HTB, NXCD = 8, WGM = 4;

__host__ __device__ __forceinline__ int lds_byte(int r, int c) { const int st = (r >> 4) * 2 + (c >> 5), rr = r & 15, cc = c & 31, ob = rr * 64 + cc * 2; return st * 1024 + (ob ^ (((ob >> 9) & 1) << 5)); }
__host__ __device__ __forceinline__ void stage_rc(int b, int& R, int& C) { const int st = b / 1024, sb = b % 1024, swz = sb ^ (((sb >> 9) & 1) << 5); R = (st >> 1) * 16 + swz / 64; C = (st & 1) * 32 + (swz % 64) / 2; }
__host__ __device__ __forceinline__ int perm32(int rho) { const int n = rho >> 4, i = rho & 15; return 8 * (i >> 2) + 4 * n + (i & 3); }

struct Unit { int pm, pn; };
struct Gemm { const bf16_t* A; const bf16_t* Bt; int M, N, K; };

struct StaticOrder {
    int nM, nN, nwg, G, c;
    __host__ __device__ void init(int M, int N, int G_, int c_) { nM = M / BM; nN = N / BM; nwg = nM * nN; G = G_; c = c_; }
    __host__ __device__ bool next(int i, Unit& u) const {
        const long L = (long)i * G + c; if (L >= nwg) return false;
        int wgid = (int)L; { const int q = nwg / NXCD, r = nwg % NXCD, xcd = wgid % NXCD, off = wgid / NXCD; wgid = (xcd < r ? xcd * (q + 1) : r * (q + 1) + (xcd - r) * q) + off; }
        const int nig = WGM * nN, gid = wgid / nig, fm = gid * WGM, gsz = (nM - fm) < WGM ? (nM - fm) : WGM;
        u.pm = fm + ((wgid % nig) % gsz); u.pn = (wgid % nig) / gsz; return true;
    }
    __device__ __forceinline__ void a_ready(const Unit&) const {}
    __device__ __forceinline__ void done(const Unit&) const {}
};

__device__ __forceinline__ unsigned cvt_pk_bf16(float lo, float hi) { unsigned r; asm volatile("v_cvt_pk_bf16_f32 %0, %1, %2" : "=v"(r) : "v"(lo), "v"(hi)); return r; }
typedef float f32x2 __attribute__((ext_vector_type(2)));
__device__ __forceinline__ f32x2 gelu_pk(f32x2 v) {
    const f32x2 av = __builtin_elementwise_abs(v), d = av * 0.2316418882f + 1.0f;
    f32x2 t; t.x = __builtin_amdgcn_rcpf(d.x); t.y = __builtin_amdgcn_rcpf(d.y);
    f32x2 q = t * 0.5307027145f + (-0.7265760135f); q = q * t + 0.7107068705f; q = q * t + (-0.142248368f); q = q * t + 0.127414796f; q = q * t;
    const f32x2 s = (v * v) * (-0.72134752044f);
    f32x2 e; e.x = __builtin_amdgcn_exp2f(s.x); e.y = __builtin_amdgcn_exp2f(s.y);
    const f32x2 m = v * (q * e), r = v - m;
    f32x2 o; o.x = v.x < 0.f ? m.x : r.x; o.y = v.y < 0.f ? m.y : r.y; return o;
}

template <class Epi, class Sched, bool ALIGN_EPI = false, bool SP2 = false>
__device__ __forceinline__ void gemm_phase(PG8_LAS unsigned char* lds, const Gemm g, const Sched& S, const Epi& E) {
    int tid_o = threadIdx.x; asm volatile("" : "+v"(tid_o));
    const int tid = tid_o, wid = __builtin_amdgcn_readfirstlane(tid >> 6), lane = tid & 63, wr = wid >> 2, wc = wid & 3, fr = lane & 15, fq = lane >> 4;
    const int K = g.K, nt = K / BK;
    unsigned voffA[2], voffB[2];
#pragma unroll
    for (int i = 0; i < 2; ++i) { int R, C; stage_rc(tid * 16 + i * 8192, R, C); const int Rb = Epi::PERM ? ((R & ~31) + perm32(R & 31)) : R;
        voffA[i] = (unsigned)(R * K + C) * 2u; voffB[i] = (unsigned)(Rb * K + C) * 2u; }
    const size_t kstep = (size_t)(BK * 2);
    const size_t hstep = (size_t)HALF * K * 2;
    const size_t tstep = 2 * hstep;
    const unsigned ldsw = (unsigned)wid * 1024u;
    const int aoff = lds_byte(wr * 64 + fr, fq * 8), boff = lds_byte(wc * 32 + fr, fq * 8);
#define PG8_SA(b, h) (((b) * 2 + (h)) * HTB)
#define PG8_SB(b, h) ((4 + (b) * 2 + (h)) * HTB)
#define PG8_STAGE(bufoff, gbase, voff) do { _Pragma("unroll") for (int _i = 0; _i < 2; ++_i) \
        __builtin_amdgcn_global_load_lds((const unsigned*)((const char*)(gbase) + (voff)[_i]), (PG8_LAS unsigned*)(lds + (bufoff) + ldsw + _i * 8192), 16, 0, 0); } while (0)
#define PG8_LDA(dst, b, h) do { _Pragma("unroll") for (int m = 0; m < 4; ++m) _Pragma("unroll") for (int k = 0; k < 2; ++k) dst[m][k] = *(const PG8_LAS bf16x8*)(lds + PG8_SA(b, h) + aoff + m * 2048 + k * 1024); } while (0)
#define PG8_LDB(dst, b, h) do { _Pragma("unroll") for (int n = 0; n < 2; ++n) _Pragma("unroll") for (int k = 0; k < 2; ++k) dst[n][k] = *(const PG8_LAS bf16x8*)(lds + PG8_SB(b, h) + boff + n * 2048 + k * 1024); } while (0)
#define PG8_MMA(ai, bj, At, Bt) do { __builtin_amdgcn_s_setprio(1); _Pragma("unroll") for (int m = 0; m < 4; ++m) _Pragma("unroll") for (int n = 0; n < 2; ++n) _Pragma("unroll") for (int k = 0; k < 2; ++k) \
        acc[ai][bj][m][n] = __builtin_amdgcn_mfma_f32_16x16x32_bf16(Bt[n][k], At[m][k], acc[ai][bj][m][n], 0, 0, 0); __builtin_amdgcn_s_setprio(0); } while (0)
#define PG8_WAIT_V(n) asm volatile("s_waitcnt vmcnt(" #n ")" ::: "memory")
#define PG8_WAIT_L(n) asm volatile("s_waitcnt lgkmcnt(" #n ")" ::: "memory")
#define PG8_BAR __builtin_amdgcn_s_barrier()
#define PG8_SCHED __builtin_amdgcn_sched_barrier(0)
    Unit cur, nxt; int ui = 0;
    if (!S.next(0, cur)) return;
    f32x4 acc[2][2][4][2];
#pragma unroll
    for (int a = 0; a < 2; ++a)
#pragma unroll
        for (int b = 0; b < 2; ++b)
#pragma unroll
            for (int m = 0; m < 4; ++m)
#pragma unroll
                for (int n = 0; n < 2; ++n) acc[a][b][m][n] = (f32x4){0.f, 0.f, 0.f, 0.f};
    bf16x8 At[4][2], B0[2][2], B1[2][2];
    const char* cA = (const char*)g.A + (size_t)cur.pm * tstep; const char* cB = (const char*)g.Bt + (size_t)cur.pn * tstep;
    S.a_ready(cur);
    { const auto pr0 = E.prep_issue(cur, tid); E.prep_commit(lds, pr0, 0, tid); }
    if constexpr (SP2) {
        PG8_STAGE(PG8_SB(0, 0), cB, voffB); PG8_STAGE(PG8_SB(0, 1), cB + hstep, voffB); PG8_STAGE(PG8_SA(0, 0), cA, voffA); PG8_STAGE(PG8_SA(0, 1), cA + hstep, voffA);
        if (wr == 1) PG8_BAR;
        PG8_WAIT_V(2); PG8_BAR;
        PG8_STAGE(PG8_SB(1, 0), cB + kstep, voffB); PG8_STAGE(PG8_SA(1, 0), cA + kstep, voffA); PG8_STAGE(PG8_SB(1, 1), cB + hstep + kstep, voffB);
        PG8_WAIT_V(6); PG8_BAR;
    } else {
        PG8_STAGE(PG8_SB(0, 0), cB, voffB); PG8_STAGE(PG8_SA(0, 0), cA, voffA); PG8_STAGE(PG8_SB(0, 1), cB + hstep, voffB); PG8_STAGE(PG8_SA(0, 1), cA + hstep, voffA);
        if (wr == 1) PG8_BAR;
        PG8_WAIT_V(4); PG8_BAR;
        PG8_STAGE(PG8_SB(1, 0), cB + kstep, voffB); PG8_STAGE(PG8_SA(1, 0), cA + kstep, voffA); PG8_STAGE(PG8_SB(1, 1), cB + hstep + kstep, voffB);
        PG8_WAIT_V(6); PG8_BAR;
    }
    for (;;) {
        const bool has_next = S.next(ui + 1, nxt);
        const char* nA = has_next ? (const char*)g.A + (size_t)nxt.pm * tstep : cA; const char* nB = has_next ? (const char*)g.Bt + (size_t)nxt.pn * tstep : cB;
        for (int t = 0; t < nt; t += 2) {
            const bool last = (t == nt - 2);
            const char* a1 = cA + (size_t)(t + 1) * kstep;
            const char* a2 = last ? nA : cA + (size_t)(t + 2) * kstep; const char* b2 = last ? nB : cB + (size_t)(t + 2) * kstep;
            const char* a3 = a2 + kstep; const char* b3 = b2 + kstep;
            if (last && has_next) S.a_ready(nxt);
            if constexpr (SP2) {
            PG8_LDB(B0, 0, 0); PG8_LDB(B1, 0, 1); PG8_SCHED; PG8_LDA(At, 0, 0); PG8_STAGE(PG8_SA(1, 1), a1 + hstep, voffA);
            PG8_WAIT_V(8); PG8_WAIT_L(0); PG8_BAR; PG8_MMA(0, 0, At, B0); PG8_MMA(0, 1, At, B1); PG8_BAR; PG8_SCHED;
            PG8_LDA(At, 0, 1); PG8_STAGE(PG8_SB(0, 0), b2, voffB); PG8_STAGE(PG8_SB(0, 1), b2 + hstep, voffB); PG8_STAGE(PG8_SA(0, 0), a2, voffA);
            PG8_WAIT_V(8); PG8_WAIT_L(0); PG8_BAR; PG8_MMA(1, 0, At, B0); PG8_MMA(1, 1, At, B1); PG8_BAR; PG8_SCHED;
            PG8_LDB(B0, 1, 0); PG8_LDB(B1, 1, 1); PG8_SCHED; PG8_LDA(At, 1, 0); PG8_STAGE(PG8_SA(0, 1), a2 + hstep, voffA);
            PG8_WAIT_V(8); PG8_WAIT_L(0); PG8_BAR; PG8_MMA(0, 0, At, B0); PG8_MMA(0, 1, At, B1); PG8_BAR; PG8_SCHED;
            PG8_LDA(At, 1, 1); PG8_STAGE(PG8_SB(1, 0), b3, voffB); PG8_STAGE(PG8_SB(1, 1), b3 + hstep, voffB); PG8_STAGE(PG8_SA(1, 0), a3, voffA);
            PG8_WAIT_V(8); PG8_WAIT_L(0); PG8_BAR; PG8_MMA(1, 0, At, B0); PG8_MMA(1, 1, At, B1); PG8_BAR; PG8_SCHED;
            } else {
            PG8_LDB(B0, 0, 0); PG8_SCHED; PG8_LDA(At, 0, 0); PG8_STAGE(PG8_SA(1, 1), a1 + hstep, voffA);
            PG8_WAIT_L(8); PG8_BAR; PG8_WAIT_L(0); PG8_MMA(0, 0, At, B0); PG8_BAR; PG8_SCHED;
            PG8_LDB(B1, 0, 1); PG8_STAGE(PG8_SB(0, 0), b2, voffB);
            PG8_BAR; PG8_WAIT_L(0); PG8_MMA(0, 1, At, B1); PG8_BAR;
            PG8_LDA(At, 0, 1); PG8_STAGE(PG8_SA(0, 0), a2, voffA);
            PG8_BAR; PG8_WAIT_L(0); PG8_MMA(1, 0, At, B0); PG8_BAR; PG8_SCHED;
            PG8_STAGE(PG8_SB(0, 1), b2 + hstep, voffB);
            PG8_WAIT_V(6); PG8_BAR; PG8_MMA(1, 1, At, B1); PG8_BAR;
            PG8_LDB(B0, 1, 0); PG8_SCHED; PG8_LDA(At, 1, 0); PG8_STAGE(PG8_SA(0, 1), a2 + hstep, voffA);
            PG8_WAIT_L(8); PG8_BAR; PG8_WAIT_L(0); PG8_MMA(0, 0, At, B0); PG8_BAR; PG8_SCHED;
            PG8_LDB(B1, 1, 1); PG8_STAGE(PG8_SB(1, 0), b3, voffB);
            PG8_BAR; PG8_WAIT_L(0); PG8_MMA(0, 1, At, B1); PG8_BAR;
            PG8_LDA(At, 1, 1); PG8_STAGE(PG8_SA(1, 0), a3, voffA);
            PG8_BAR; PG8_WAIT_L(0); PG8_MMA(1, 0, At, B0); PG8_BAR; PG8_SCHED;
            PG8_STAGE(PG8_SB(1, 1), b3 + hstep, voffB);
            PG8_WAIT_V(6); PG8_BAR; PG8_MMA(1, 1, At, B1); PG8_BAR;
            }
        }
        if constexpr (ALIGN_EPI) { if (wr == 0) PG8_BAR; }
        if constexpr (!Epi::AFTER_DRAIN) { const auto pr = E.prep_issue(has_next ? nxt : cur, tid); E.run(acc, cur, wr, wc, fr, fq, 2, lds, ui); E.prep_commit(lds, pr, ui + 1, tid); S.done(cur); }
#ifdef PROBE_EPI2
        if constexpr (Epi::IDEMP) { E.run(acc, cur, wr, wc, fr, fq, 2, lds, ui); }
#endif
        if (!has_next) break;
#pragma unroll
        for (int a = 0; a < 2; ++a)
#pragma unroll
            for (int b = 0; b < 2; ++b)
#pragma unroll
                for (int m = 0; m < 4; ++m)
#pragma unroll
                    for (int n = 0; n < 2; ++n) acc[a][b][m][n] = (f32x4){0.f, 0.f, 0.f, 0.f};
        cur = nxt; cA = nA; cB = nB; ++ui;
        if constexpr (ALIGN_EPI) { if (wr == 1) PG8_BAR; }
    }
    PG8_WAIT_V(0);
    if constexpr (!ALIGN_EPI) { if (wr == 0) PG8_BAR; }
    PG8_BAR;
    if constexpr (Epi::AFTER_DRAIN) { E.fused(acc, cur, wr, wc, fr, fq, lds, wid, lane); S.done(cur); }
#undef PG8_SA
#undef PG8_SB
#undef PG8_STAGE
#undef PG8_LDA
#undef PG8_LDB
#undef PG8_MMA
#undef PG8_WAIT_V
#undef PG8_WAIT_L
#undef PG8_BAR
#undef PG8_SCHED
}
}

using pg8::bf16_t; using pg8::bf16x8; using pg8::f32x4; using pg8::u32x4; using pg8::Unit;
typedef float f32x16 __attribute__((ext_vector_type(16)));
typedef short s16x4 __attribute__((ext_vector_type(4)));
typedef unsigned u32x2 __attribute__((ext_vector_type(2)));
#define LAS __attribute__((address_space(3)))
#define XB_TMO      128
#define XB_XCNT(j)  (256  + 64 * (j))
#define XB_XSUB(j)  (1280 + 64 * (j))
#define XB_XGEN(j)  (2304 + 64 * (j))
#define XB_TOP      3328
#define XB_TOPGEN   3392
#define XCD_BAR_WORDS 3456
#define XB_SPIN_CAP (1u << 18)

__device__ __forceinline__ unsigned xb_ld(unsigned* p)              { return __hip_atomic_load(p, __ATOMIC_RELAXED, __HIP_MEMORY_SCOPE_AGENT); }
__device__ __forceinline__ unsigned xb_add(unsigned* p, unsigned v) { return __hip_atomic_fetch_add(p, v, __ATOMIC_RELAXED, __HIP_MEMORY_SCOPE_AGENT); }
__device__ __forceinline__ unsigned xb_xcc_id() { return (unsigned)__builtin_amdgcn_s_getreg((3 << 11) | 20) & 0xFu; }
#define XB_SPIN(cond, bar) do { unsigned _sp = 0; while (cond) { __builtin_amdgcn_s_sleep(1); \
    if ((++_sp & 255u) == 0u) { if (xb_ld(&(bar)[XB_TMO])) break; if (_sp > XB_SPIN_CAP) { atomicAdd(&(bar)[XB_TMO], 1u); break; } } } } while (0)

struct XcdBarrier {
    unsigned* bar; unsigned x;
    volatile LAS unsigned* st;
};

__device__ __forceinline__ XcdBarrier xcd_barrier_post(unsigned* bar, volatile LAS unsigned* st) {
    XcdBarrier b; b.bar = bar; b.x = xb_xcc_id(); b.st = st;
    if (threadIdx.x == 0) (void)xb_add(&bar[XB_XCNT(b.x)], 1u);
    return b;
}
__device__ __forceinline__ void xcd_barrier_complete(unsigned* bar, unsigned x, unsigned& nloc, unsigned& nx) {
    const unsigned G = gridDim.x * gridDim.y * gridDim.z;
    unsigned sum, cnt, mine, sp = 0u;
    for (;;) {
        sum = 0u; cnt = 0u; mine = 0u;
#pragma unroll
        for (unsigned j = 0; j < 16; ++j) { const unsigned c = xb_ld(&bar[XB_XCNT(j)]); sum += c; cnt += (c > 0u) ? 1u : 0u; mine = (j == x) ? c : mine; }
        if (sum == G) break;
        __builtin_amdgcn_s_sleep(1);
        if ((++sp & 255u) == 0u) { if (xb_ld(&bar[XB_TMO])) break; if (sp > XB_SPIN_CAP) { atomicAdd(&bar[XB_TMO], 1u); break; } }
    }
    nloc = mine > 0u ? mine : 1u; nx = cnt > 0u ? cnt : 1u;
}

__device__ __forceinline__ void xcd_barrier(const XcdBarrier& b) {
    asm volatile("s_waitcnt vmcnt(0)" ::: "memory");
    __syncthreads();
    if (threadIdx.x == 0) {
        unsigned* bar = b.bar;
        __builtin_amdgcn_s_waitcnt(0);
        unsigned nloc = b.st[0], nx = b.st[1];
        if (nloc == 0u) { xcd_barrier_complete(bar, b.x, nloc, nx); b.st[0] = nloc; b.st[1] = nx; }
        const unsigned old = xb_add(&bar[XB_XSUB(b.x)], 1u);
        const unsigned gen = old / nloc;
        if (old + 1u == (gen + 1u) * nloc) {
            __builtin_amdgcn_fence(__ATOMIC_RELEASE, "agent");
            asm volatile("s_waitcnt vmcnt(0)" ::: "memory");
            const unsigned og = xb_add(&bar[XB_TOP], 1u);
            const unsigned tg = og / nx;
            if (og + 1u == (tg + 1u) * nx) xb_add(&bar[XB_TOPGEN], 1u);
            else XB_SPIN(xb_ld(&bar[XB_TOPGEN]) == tg, bar);
            __builtin_amdgcn_fence(__ATOMIC_ACQUIRE, "agent");
            xb_add(&bar[XB_XGEN(b.x)], 1u);
            asm volatile("s_waitcnt vmcnt(0)" ::: "memory");
        } else {
            XB_SPIN(xb_ld(&bar[XB_XGEN(b.x)]) == gen, bar);
            __builtin_amdgcn_fence(__ATOMIC_ACQUIRE, "agent");
            asm volatile("s_waitcnt vmcnt(0)" ::: "memory");
        }
    }
    __syncthreads();
}


constexpr int DM = 1024, TT = 8208, NBATCH = 4, MROWS = NBATCH * TT, MP = 33024, NIN = 2560, DFF = 2816, SEQ = 8192;
constexpr int NCH = 129;
constexpr int NQB = 65;
constexpr float EPS = 1e-6f;
__device__ constexpr float ROPE_INV[8] = {1.0f, 0.1939227432012558f, 0.03760603070259094f, 0.007292664609849453f, 0.0014142135623842478f, 0.00027424818836152554f, 5.318296098266728e-05f, 1.0313386155758053e-05f};
constexpr float C2 = 0.125f * 1.4426950408889634f;
constexpr size_t MiB = 1u << 20;
constexpr size_t WS_CTL = 0, CTL_BYTES = 32768;
constexpr size_t WS_W = 2 * MiB, W_LAYER = 24 * MiB, W_IN = 0, W_O = 5 * MiB, W_GU = 7 * MiB, W_D = 18 * MiB;
constexpr size_t WS_ROPE = 50 * MiB, WS_SSQ = 52 * MiB, WS_SUMA = 55 * MiB, WS_SUMH = 57 * MiB, WS_HM = 59 * MiB, WS_WG = 60 * MiB;
constexpr size_t WS_HB = 64 * MiB, WS_PJ = 130 * MiB, WS_HL = 292 * MiB, WS_CA = 325 * MiB, WS_MIX = 358 * MiB, WS_ACT = 130 * MiB, WS_END = 423 * MiB;
constexpr int LDS_BYTES = 147456, LDS_MISC = 139264;

typedef float f32x2_t __attribute__((ext_vector_type(2))); typedef __bf16 bf16x2_t __attribute__((ext_vector_type(2)));
__device__ __forceinline__ unsigned cvtpk(float lo, float hi) { f32x2_t v = {lo, hi}; bf16x2_t b = __builtin_convertvector(v, bf16x2_t); return __builtin_bit_cast(unsigned, b); }
__device__ __forceinline__ void row_bt(int r, int& b, int& t) { b = r / TT; t = r - b * TT; }
__device__ __forceinline__ float bf2f(unsigned short v) { return __uint_as_float((unsigned)v << 16); }
__device__ __forceinline__ u32x4 pack8(const f32x4 a, const f32x4 b) { u32x4 w; w.x = cvtpk(a[0], a[1]); w.y = cvtpk(a[2], a[3]); w.z = cvtpk(b[0], b[1]); w.w = cvtpk(b[2], b[3]); return w; }
__device__ __forceinline__ float row_rs(const float* SSQ, int r) {
    const f32x4* sp = (const f32x4*)(SSQ + (size_t)r * 16); const f32x4 a = sp[0], b = sp[1], c = sp[2], d = sp[3];
    const f32x4 s = (a + b) + (c + d); return rsqrtf(((s[0] + s[1]) + (s[2] + s[3])) * (1.0f / DM) + EPS);
}


constexpr int LDS_RSTAB = LDS_MISC + 2048;
struct PrepRegs { f32x4 a, b; };
__device__ __forceinline__ PrepRegs rs_issue(const float* SSQ, const Unit& u, int tid) { const f32x4* sp = (const f32x4*)(SSQ + (size_t)(u.pm * 256 + (tid >> 1)) * 16 + 8 * (tid & 1)); PrepRegs r; r.a = sp[0]; r.b = sp[1]; return r; }
__device__ __forceinline__ void rs_commit(LAS unsigned char* lds, const PrepRegs& r, int ui, int tid) {
    const f32x4 s4 = r.a + r.b; float s = (s4[0] + s4[1]) + (s4[2] + s4[3]); s += __shfl_xor(s, 1);
    if ((tid & 1) == 0) ((LAS float*)(lds + LDS_RSTAB))[(ui & 1) * 256 + (tid >> 1)] = rsqrtf(s * (1.0f / DM) + EPS);
}
struct EpiIn {
    static constexpr bool PERM = true, AFTER_DRAIN = false, IDEMP = true;
    bf16_t* PJ; const float* SSQ; const float* gq; const float* gk;
    __device__ __forceinline__ PrepRegs prep_issue(const Unit& u, int tid) const { return rs_issue(SSQ, u, tid); }
    __device__ __forceinline__ void prep_commit(LAS unsigned char* lds, const PrepRegs& r, int ui, int tid) const { rs_commit(lds, r, ui, tid); }
    __device__ __forceinline__ void run(const f32x4 (&acc)[2][2][4][2], const Unit& u, int wr, int wc, int fr, int fq, const int nai, LAS unsigned char* lds, const int ui) const {
        const LAS float* RT = (const LAS float*)(lds + LDS_RSTAB) + (ui & 1) * 256;
        const int pn = u.pn; const bool isqk = pn < 4;
        f32x4 gv[2][2];
#pragma unroll
        for (int bj = 0; bj < 2; ++bj)
#pragma unroll
            for (int n = 0; n < 2; ++n) gv[bj][n] = isqk ? *(const f32x4*)((pn < 2 ? gq : gk) + 32 * bj + 8 * fq + 4 * n) : (f32x4){1.f, 1.f, 1.f, 1.f};
        const float qs = (pn < 2) ? C2 : 1.f;
#pragma unroll
        for (int ai = 0; ai < nai; ++ai)
#pragma unroll
            for (int m = 0; m < 4; ++m) {
                const int r = u.pm * 256 + ai * 128 + wr * 64 + m * 16 + fr;
                const float rs = RT[ai * 128 + wr * 64 + m * 16 + fr];
                f32x4 v[2][2];
#pragma unroll
                for (int bj = 0; bj < 2; ++bj)
#pragma unroll
                    for (int n = 0; n < 2; ++n) v[bj][n] = acc[ai][bj][m][n] * rs;
                if (isqk) {
                    float q2 = 0.f;
#pragma unroll
                    for (int bj = 0; bj < 2; ++bj)
#pragma unroll
                        for (int n = 0; n < 2; ++n) { const f32x4 x = v[bj][n]; q2 += (x[0] * x[0] + x[1] * x[1]) + (x[2] * x[2] + x[3] * x[3]); }
                    q2 += __shfl_xor(q2, 16); q2 += __shfl_xor(q2, 32);
                    const float rn = rsqrtf(q2 * (1.0f / 64.0f) + EPS);
#pragma unroll
                    for (int bj = 0; bj < 2; ++bj)
#pragma unroll
                        for (int n = 0; n < 2; ++n) v[bj][n] = v[bj][n] * rn * gv[bj][n];
                    int b, t; row_bt(r, b, t);
#pragma unroll
                    for (int n = 0; n < 2; ++n) {
                        f32x4 o; o[0] = __shfl_xor(v[0][n][0], 16); o[1] = __shfl_xor(v[0][n][1], 16); o[2] = __shfl_xor(v[0][n][2], 16); o[3] = __shfl_xor(v[0][n][3], 16);
                        f32x4 c, s;
#pragma unroll
                        for (int i = 0; i < 4; ++i) {
                            const float angf = (float)t * ROPE_INV[4 * n + i];
                            const float pr_ = angf * 0.15915494f, er_ = __builtin_fmaf(angf, 0.15915494f, -pr_);
                            const float rev = __builtin_amdgcn_fractf(pr_) + __builtin_fmaf(angf, (float)(0.15915494309189535 - (double)0.15915494f), er_);
                            c[i] = __builtin_amdgcn_cosf(rev); s[i] = __builtin_amdgcn_sinf(rev); }
                        v[0][n] = (fq == 0) ? (v[0][n] * c - o * s) : ((fq == 1) ? (v[0][n] * c + o * s) : v[0][n]);
                    }
#pragma unroll
                    for (int bj = 0; bj < 2; ++bj)
#pragma unroll
                        for (int n = 0; n < 2; ++n) v[bj][n] = v[bj][n] * qs;
                }
                bf16_t* rowp = PJ + (size_t)r * NIN + pn * 256 + wc * 64 + 8 * fq;
#pragma unroll
                for (int bj = 0; bj < 2; ++bj) *(u32x4*)(rowp + 32 * bj) = pack8(v[bj][0], v[bj][1]);
            }
    }
};

struct EpiRes {
    static constexpr bool PERM = true, AFTER_DRAIN = false, IDEMP = false;
    float* out; bf16_t* HB; float* SSQ; int final;
    __device__ __forceinline__ void operator()(const f32x4 (&acc)[2][2][4][2], const Unit& u, int wr, int wc, int fr, int fq) const { run(acc, u, wr, wc, fr, fq, 2, nullptr, 0); }
    __device__ __forceinline__ int prep_issue(const Unit&, int) const { return 0; }
    __device__ __forceinline__ void prep_commit(LAS unsigned char*, int, int, int) const {}
    __device__ __forceinline__ void run(const f32x4 (&acc)[2][2][4][2], const Unit& u, int wr, int wc, int fr, int fq, const int nai, LAS unsigned char* lds, const int ui) const {
        const int pn = u.pn, col = pn * 256 + wc * 64 + 8 * fq;
#pragma unroll
        for (int ai = 0; ai < nai; ++ai) {
            if (u.pm * 256 + ai * 128 + wr * 64 >= MROWS) continue;
            u32x4 pre[4][2];
#pragma unroll
            for (int m = 0; m < 4; ++m) {
                const int r = u.pm * 256 + ai * 128 + wr * 64 + m * 16 + fr;
#pragma unroll
                for (int bj = 0; bj < 2; ++bj) pre[m][bj] = *(const u32x4*)(HB + (size_t)r * DM + col + 32 * bj);
            }
#pragma unroll
            for (int m = 0; m < 4; ++m) {
                const int r = u.pm * 256 + ai * 128 + wr * 64 + m * 16 + fr;
                int b, t; row_bt(r, b, t);
                float ss = 0.f;
#pragma unroll
                for (int bj = 0; bj < 2; ++bj) {
                    const u32x4 pw = pre[m][bj];
                    const f32x4 b0 = {__uint_as_float(pw[0] << 16), __uint_as_float(pw[0] & 0xffff0000u), __uint_as_float(pw[1] << 16), __uint_as_float(pw[1] & 0xffff0000u)};
                    const f32x4 b1 = {__uint_as_float(pw[2] << 16), __uint_as_float(pw[2] & 0xffff0000u), __uint_as_float(pw[3] << 16), __uint_as_float(pw[3] & 0xffff0000u)};
                    const f32x4 h0 = b0 + acc[ai][bj][m][0], h1 = b1 + acc[ai][bj][m][1];
                    if (final) { if (t >= 16) { float* op = out + (size_t)(b * SEQ + t - 16) * DM + col + 32 * bj; *(f32x4*)op = h0; *(f32x4*)(op + 4) = h1; } }
                    else {
                        ss += (h0[0] * h0[0] + h0[1] * h0[1]) + (h0[2] * h0[2] + h0[3] * h0[3]) + (h1[0] * h1[0] + h1[1] * h1[1]) + (h1[2] * h1[2] + h1[3] * h1[3]);
                        *(u32x4*)(HB + (size_t)r * DM + col + 32 * bj) = pack8(h0, h1); }
                }
                if (!final) { ss += __shfl_xor(ss, 16); ss += __shfl_xor(ss, 32); if (fq == 0) SSQ[(size_t)r * 16 + pn * 4 + wc] = ss; }
            }
        }
    }
};

struct EpiGU {
    static constexpr bool PERM = true, AFTER_DRAIN = false, IDEMP = true;
    bf16_t* ACT; const float* SSQ;
    __device__ __forceinline__ PrepRegs prep_issue(const Unit& u, int tid) const { return rs_issue(SSQ, u, tid); }
    __device__ __forceinline__ void prep_commit(LAS unsigned char* lds, const PrepRegs& r, int ui, int tid) const { rs_commit(lds, r, ui, tid); }
    __device__ __forceinline__ void run(const f32x4 (&acc)[2][2][4][2], const Unit& u, int wr, int wc, int fr, int fq, const int nai, LAS unsigned char* lds, const int ui) const {
        const LAS float* RT = (const LAS float*)(lds + LDS_RSTAB) + (ui & 1) * 256;
#pragma unroll
        for (int ai = 0; ai < nai; ++ai)
#pragma unroll
            for (int m = 0; m < 4; ++m) {
                const int r = u.pm * 256 + ai * 128 + wr * 64 + m * 16 + fr;
                const float rs = RT[ai * 128 + wr * 64 + m * 16 + fr];
                f32x4 a[2];
#pragma unroll
                for (int n = 0; n < 2; ++n) {
                    const f32x4 g = acc[ai][0][m][n] * rs, uu = acc[ai][1][m][n] * rs;
#pragma unroll
                    for (int i = 0; i < 4; ++i) a[n][i] = g[i] * uu[i] * __builtin_amdgcn_rcpf(1.0f + __expf(-g[i]));
                }
                *(u32x4*)(ACT + (size_t)r * DFF + u.pn * 128 + wc * 32 + 8 * fq) = pack8(a[0], a[1]);
            }
    }
};


constexpr int MMAIN = 32768;
template <class Epi, int K>
__device__ __forceinline__ void gemm_tail(LAS unsigned char* lds, const bf16_t* A, const bf16_t* Bt, const int N, const Epi& E, const int bid, const int G, const int tid_in) {
    int tid = tid_in; asm volatile("" : "+v"(tid));
    const int lane = tid & 63, wid = __builtin_amdgcn_readfirstlane(tid >> 6), i16 = lane & 15, kq = lane >> 4;
    constexpr int kw = K / 8, NS = kw / 32;
    const int nItems = (N >> 8) * 4;
    for (int item = bid; item < nItems; item += G) {
        const int pn = item >> 2, wc = item & 3;
        Unit ut; ut.pm = MMAIN / 256; ut.pn = pn;
        const auto prt = E.prep_issue(ut, tid);
        const bf16_t* ap = A + (size_t)(MMAIN + i16) * K + wid * kw + 8 * kq;
        const bf16_t* bp = Bt + (size_t)(256 * pn + 32 * wc + 8 * (i16 >> 2) + (i16 & 3)) * K + wid * kw + 8 * kq;
        f32x4 acc[2][4][2];
#pragma unroll
        for (int bj = 0; bj < 2; ++bj)
#pragma unroll
            for (int m = 0; m < 4; ++m)
#pragma unroll
                for (int n = 0; n < 2; ++n) acc[bj][m][n] = (f32x4){0.f, 0.f, 0.f, 0.f};
#pragma unroll
        for (int sb = 0; sb < NS; sb += 4) {
            bf16x8 af[4][4], bf[4][2][2];
#pragma unroll
            for (int s = 0; s < 4; ++s) if (sb + s < NS) {
#pragma unroll
                for (int m = 0; m < 4; ++m) af[s][m] = *(const bf16x8*)(ap + (size_t)(16 * m) * K + 32 * (sb + s));
#pragma unroll
                for (int bj = 0; bj < 2; ++bj)
#pragma unroll
                    for (int n = 0; n < 2; ++n) bf[s][bj][n] = *(const bf16x8*)(bp + (size_t)(128 * bj + 4 * n) * K + 32 * (sb + s));
            }
#pragma unroll
            for (int s = 0; s < 4; ++s) if (sb + s < NS) {
#pragma unroll
                for (int bj = 0; bj < 2; ++bj)
#pragma unroll
                    for (int m = 0; m < 4; ++m)
#pragma unroll
                        for (int n = 0; n < 2; ++n) acc[bj][m][n] = __builtin_amdgcn_mfma_f32_16x16x32_bf16(bf[s][bj][n], af[s][m], acc[bj][m][n], 0, 0, 0);
            }
        }
        E.prep_commit(lds, prt, 0, tid);
        LAS f32x4* P = (LAS f32x4*)lds;
#pragma unroll
        for (int bj = 0; bj < 2; ++bj)
#pragma unroll
            for (int m = 0; m < 4; ++m)
#pragma unroll
                for (int n = 0; n < 2; ++n) P[(wid * 16 + bj * 8 + m * 2 + n) * 64 + lane] = acc[bj][m][n];
        __syncthreads();
        if (wid == 0) {
            f32x4 full[2][2][4][2];
#pragma unroll
            for (int bj = 0; bj < 2; ++bj)
#pragma unroll
                for (int m = 0; m < 4; ++m)
#pragma unroll
                    for (int n = 0; n < 2; ++n) { full[0][bj][m][n] = acc[bj][m][n]; full[1][bj][m][n] = (f32x4){0.f, 0.f, 0.f, 0.f}; }
#pragma unroll 1
            for (int w = 1; w < 8; ++w) {
#pragma unroll
                for (int bj = 0; bj < 2; ++bj)
#pragma unroll
                    for (int m = 0; m < 4; ++m)
#pragma unroll
                        for (int n = 0; n < 2; ++n) full[0][bj][m][n] += P[(w * 16 + bj * 8 + m * 2 + n) * 64 + lane];
                asm volatile("" ::: "memory");
            }
            Unit u; u.pm = MMAIN / 256; u.pn = pn;
            E.run(full, u, 0, wc, lane & 15, lane >> 4, 1, lds, 0);
        }
        __syncthreads();
    }
}
__device__ __forceinline__ unsigned f2bf(float f) { unsigned u = __float_as_uint(f); return (u + 0x7fffu + ((u >> 16) & 1u)) >> 16; }
__device__ __forceinline__ unsigned pk2(float lo, float hi) { return f2bf(lo) | (f2bf(hi) << 16); }
__device__ __forceinline__ void transpose_item(const float* W, int K, int Nsrc, bf16_t* WT, int n0, int src_col0, int k0, const float* gk, LAS float* scr, int lane) {
    float wv[32];
#pragma unroll
    for (int i = 0; i < 32; ++i) wv[i] = W[(size_t)(k0 + 2 * i + (lane >> 5)) * Nsrc + src_col0 + (lane & 31)];
#pragma unroll
    for (int i = 0; i < 32; ++i) { const int kk = 2 * i + (lane >> 5); float v = wv[i]; if (gk) v *= gk[k0 + kk]; scr[kk * 33 + (lane & 31)] = v; }
    asm volatile("s_waitcnt lgkmcnt(0)" ::: "memory");
    const int c = lane & 7;
#pragma unroll
    for (int j = 0; j < 4; ++j) { const int n = (lane >> 3) + 8 * j; const LAS float* s = scr + (8 * c) * 33 + n;
        u32x4 o; o.x = pk2(s[0 * 33], s[1 * 33]); o.y = pk2(s[2 * 33], s[3 * 33]); o.z = pk2(s[4 * 33], s[5 * 33]); o.w = pk2(s[6 * 33], s[7 * 33]);
        *(u32x4*)(WT + (size_t)(n0 + n) * K + k0 + 8 * c) = o; }
    asm volatile("s_waitcnt lgkmcnt(0)" ::: "memory");
}
__device__ __forceinline__ int perm_src(int n0) { const int pn = n0 >> 8, rem = n0 & 255, bj = rem >> 7, wc = (rem >> 5) & 3; return pn * 256 + wc * 64 + bj * 32; }
__device__ __forceinline__ int gu_src(int n0) { const int pn = n0 >> 8, rem = n0 & 255, bj = rem >> 7, wc = (rem >> 5) & 3; return bj * DFF + pn * 128 + wc * 32; }

struct Params { const float* in[23]; float* out; unsigned char* ws; };

__device__ __forceinline__ void prologue(const Params& p, LAS unsigned char* lds, int bid, int G, int tid_in) {
    int tid = tid_in; asm volatile("" : "+v"(tid));
    const int lane = tid & 63, wave = tid >> 6;
    LAS float* scr = (LAS float*)(lds + wave * 16384);
    const int gw = bid * 8 + wave, NGW = G * 8;
    constexpr int I_IN = 16 * 80, I_O = 16 * 32, I_GU = 16 * 176, I_D = 44 * 32, I_L = I_IN + I_O + I_GU + I_D;
    for (int it = gw; it < 2 * I_L; it += NGW) {
        const int l = it / I_L; int r = it - l * I_L;
        unsigned char* wl = p.ws + WS_W + (size_t)l * W_LAYER;
        if (r < I_IN) { const int kb = r / 80, nb = r % 80; transpose_item(p.in[3] + (size_t)l * DM * NIN, DM, NIN, (bf16_t*)(wl + W_IN), 32 * nb, perm_src(32 * nb), 64 * kb, p.in[2] + l * DM, scr, lane); continue; } r -= I_IN;
        if (r < I_O) { const int kb = r / 32, nb = r % 32; transpose_item(p.in[19] + (size_t)l * DM * DM, DM, DM, (bf16_t*)(wl + W_O), 32 * nb, perm_src(32 * nb), 64 * kb, nullptr, scr, lane); continue; } r -= I_O;
        if (r < I_GU) { const int kb = r / 176, nb = r % 176; transpose_item(p.in[21] + (size_t)l * DM * 2 * DFF, DM, 2 * DFF, (bf16_t*)(wl + W_GU), 32 * nb, gu_src(32 * nb), 64 * kb, p.in[20] + l * DM, scr, lane); continue; } r -= I_GU;
        { const int kb = r / 32, nb = r % 32; transpose_item(p.in[22] + (size_t)l * DFF * DM, DFF, DM, (bf16_t*)(wl + W_D), 32 * nb, perm_src(32 * nb), 64 * kb, nullptr, scr, lane); }
    }
    bf16_t* HB = (bf16_t*)(p.ws + WS_HB); float* SSQ = (float*)(p.ws + WS_SSQ); bf16_t* MIX = (bf16_t*)(p.ws + WS_MIX);
    for (int m0 = gw; m0 < MP; m0 += 2 * NGW) {
        f32x4 v[2][4];
#pragma unroll
        for (int q = 0; q < 2; ++q) { const int m = m0 + q * NGW;
            if (m < MROWS) { int b, t; row_bt(m, b, t);
                const f32x4* xr = (const f32x4*)(t < 16 ? p.in[1] + (size_t)t * DM : p.in[0] + (size_t)(b * SEQ + t - 16) * DM) + lane;
#pragma unroll
                for (int j = 0; j < 4; ++j) v[q][j] = xr[64 * j];
            } else {
#pragma unroll
                for (int j = 0; j < 4; ++j) v[q][j] = (f32x4){0.f, 0.f, 0.f, 0.f};
            } }
#pragma unroll
        for (int q = 0; q < 2; ++q) { const int m = m0 + q * NGW; if (m >= MP) continue;
            float s = 0.f;
#pragma unroll
            for (int j = 0; j < 4; ++j) s += (v[q][j][0] * v[q][j][0] + v[q][j][1] * v[q][j][1]) + (v[q][j][2] * v[q][j][2] + v[q][j][3] * v[q][j][3]);
            if (m >= MROWS) { u32x2* mo = (u32x2*)(MIX + (size_t)m * DM) + lane;
#pragma unroll
                for (int j = 0; j < 4; ++j) mo[64 * j] = (u32x2){0u, 0u}; }
#pragma unroll
            for (int o = 1; o < 64; o <<= 1) s += __shfl_xor(s, o);
            u32x2* ho = (u32x2*)(HB + (size_t)m * DM) + lane;
#pragma unroll
            for (int j = 0; j < 4; ++j) ho[64 * j] = (u32x2){cvtpk(v[q][j][0], v[q][j][1]), cvtpk(v[q][j][2], v[q][j][3])};
            if (lane < 16) SSQ[(size_t)m * 16 + lane] = (lane == 0) ? s : 0.f; }
    }
    { bf16_t* WG = (bf16_t*)(p.ws + WS_WG);
      for (int idx = bid * 512 + tid; idx < 2 * 2 * 8 * 4096; idx += G * 512) { const int d = idx & 63, e = (idx >> 6) & 63, n = (idx >> 12) & 7, g = (idx >> 15) & 1, l = idx >> 16;
          WG[idx] = (bf16_t)f2bf(p.in[g == 0 ? 13 : 15][(size_t)((l * 8 + n) * 64 + d) * 64 + e]); } }
}

struct RecArgs { const bf16_t* PJ; bf16_t* HL; bf16_t* CA; float* SUMA; float* SUMH; bf16_t* MIX;
                 const float *conv_w, *conv_b, *b_rg, *b_ig, *lruL, *recg; const bf16_t* wgt; };
constexpr int XC_STRIDE = 1040;

__device__ __forceinline__ void rec_et(LAS unsigned char* lds, const RecArgs& a, const bf16_t* Wr, const bf16_t* Wi, const int et, const int n, const int r32, const int hi,
                                       const int b, const int c, const int t0, const int nvalid, LAS float* Pbrg, LAS float* Pbig, LAS float* Plsl) {
            float A0[16], H0[16];
#pragma unroll
            for (int r = 0; r < 16; ++r) { A0[r] = 1.0f; H0[r] = 0.f; }
            const int ntt = nvalid > 32 ? 2 : 1;
#pragma unroll 1
            for (int tt = 0; tt < ntt; ++tt) {
                f32x16 accr = {}, acci = {};
#pragma unroll
                for (int kk = 0; kk < 4; ++kk) { const bf16x8 xb = *(const LAS bf16x8*)(lds + (32 * tt + r32) * XC_STRIDE + (64 * n + 16 * kk + 8 * hi) * 2);
                    const bf16x8 war = *(const bf16x8*)(Wr + (32 * et + r32) * 64 + 16 * kk + 8 * hi), wai = *(const bf16x8*)(Wi + (32 * et + r32) * 64 + 16 * kk + 8 * hi);
                    accr = __builtin_amdgcn_mfma_f32_32x32x16_bf16(war, xb, accr, 0, 0, 0);
                    acci = __builtin_amdgcn_mfma_f32_32x32x16_bf16(wai, xb, acci, 0, 0, 0); }
                const int tok = 32 * tt + r32, t = t0 + tok; const bool valid = tok < nvalid;
                float av[16], uv[16];
#pragma unroll
                for (int r = 0; r < 16; ++r) { const int ch = 64 * n + 32 * et + (r & 3) + 8 * (r >> 2) + 4 * hi;
                    const float xcv = bf2f(*(const LAS unsigned short*)(lds + tok * XC_STRIDE + ch * 2));
                    const float rg = __builtin_amdgcn_rcpf(1.0f + __expf(-(accr[r] + Pbrg[ch]))), ig = __builtin_amdgcn_rcpf(1.0f + __expf(-(acci[r] + Pbig[ch])));
                    const float la = rg * Plsl[ch]; float aa = __expf(la); float mult = __builtin_amdgcn_sqrtf(fmaxf(__builtin_fmaf(-aa, aa, 1.0f), 0.f)); if (t == 0) mult = 1.0f;
                    float uu = mult * ig * xcv; if (!valid) { aa = 1.0f; uu = 0.f; }
                    av[r] = aa; uv[r] = uu; }
#define DPP_F(OLD, X, CTRL, RM) __builtin_amdgcn_update_dpp((OLD), (X), (CTRL), (RM), 0xf, false)
#define SCAN_STEP(CTRL, RM) do { _Pragma("unroll") for (int r = 0; r < 16; ++r) { const float ap = DPP_F(1.0f, av[r], CTRL, RM), up = DPP_F(0.0f, uv[r], CTRL, RM); uv[r] = __builtin_fmaf(av[r], up, uv[r]); av[r] = av[r] * ap; } } while (0)
                SCAN_STEP(0x111, 0xf); SCAN_STEP(0x112, 0xf); SCAN_STEP(0x114, 0xf); SCAN_STEP(0x118, 0xf);
                SCAN_STEP(0x142, 0xa);
#undef SCAN_STEP
#undef DPP_F
                if (tt == 0) {
#pragma unroll
                    for (int r = 0; r < 16; ++r) { A0[r] = __shfl(av[r], 31, 32); H0[r] = __shfl(uv[r], 31, 32); }
                } else {
#pragma unroll
                    for (int r = 0; r < 16; ++r) { uv[r] = av[r] * H0[r] + uv[r]; av[r] = av[r] * A0[r]; }
                }
                if (valid) {
#pragma unroll
                    for (int g4 = 0; g4 < 4; ++g4) { const int ch0 = 64 * n + 32 * et + 8 * g4 + 4 * hi; const size_t off = (size_t)(b * TT + t) * 512 + ch0;
                        *(u32x2*)(a.HL + off) = (u32x2){cvtpk(uv[4 * g4], uv[4 * g4 + 1]), cvtpk(uv[4 * g4 + 2], uv[4 * g4 + 3])};
                        *(u32x2*)(a.CA + off) = (u32x2){cvtpk(av[4 * g4], av[4 * g4 + 1]), cvtpk(av[4 * g4 + 2], av[4 * g4 + 3])}; }
                }
                if (tt == ntt - 1 && r32 == 31) {
#pragma unroll
                    for (int g4 = 0; g4 < 4; ++g4) { const int ch0 = 64 * n + 32 * et + 8 * g4 + 4 * hi; const size_t off = (size_t)(b * NCH + c) * 512 + ch0;
                        *(f32x4*)(a.SUMA + off) = (f32x4){av[4 * g4], av[4 * g4 + 1], av[4 * g4 + 2], av[4 * g4 + 3]};
                        *(f32x4*)(a.SUMH + off) = (f32x4){uv[4 * g4], uv[4 * g4 + 1], uv[4 * g4 + 2], uv[4 * g4 + 3]}; }
                }
            }
        }

__device__ __forceinline__ void rec_local_phase(LAS unsigned char* lds, const RecArgs& a, int bid, int G, int tid_in) {
    int tid = tid_in; asm volatile("" : "+v"(tid));
    const int lane = tid & 63, wid = __builtin_amdgcn_readfirstlane(tid >> 6), r32 = lane & 31, hi = lane >> 5;
    LAS float* Pbrg = (LAS float*)(lds + 66560); LAS float* Pbig = Pbrg + 512; LAS float* Plsl = Pbig + 512;
    Pbrg[tid] = a.b_rg[tid]; Pbig[tid] = a.b_ig[tid]; { const float L = a.lruL[tid]; Plsl[tid] = -8.0f * log1pf(__expf(-L)); }
    const bf16_t* Wr = a.wgt + (size_t)wid * 4096; const bf16_t* Wi = Wr + 8 * 4096;
    __syncthreads();
    for (int item = bid; item < NBATCH * NCH; item += G) {
        const int b = item < 512 ? (item >> 7) : (item - 512), c = item < 512 ? (item & 127) : 128, t0 = 64 * c, nvalid = (TT - t0) < 64 ? (TT - t0) : 64;
        if (8 * wid < nvalid) {
            float cw[4][8], cb[8];
#pragma unroll
            for (int k = 0; k < 4; ++k) { const f32x4 w0 = *(const f32x4*)(a.conv_w + k * 512 + 8 * lane), w1 = *(const f32x4*)(a.conv_w + k * 512 + 8 * lane + 4);
#pragma unroll
                for (int j = 0; j < 4; ++j) { cw[k][j] = w0[j]; cw[k][4 + j] = w1[j]; } }
            { const f32x4 w0 = *(const f32x4*)(a.conv_b + 8 * lane), w1 = *(const f32x4*)(a.conv_b + 8 * lane + 4);
#pragma unroll
                for (int j = 0; j < 4; ++j) { cb[j] = w0[j]; cb[4 + j] = w1[j]; } }
            u32x4 raws[11];
#pragma unroll
            for (int k = 0; k < 11; ++k) { const int t = t0 + 8 * wid - 3 + k; raws[k] = (u32x4){0u, 0u, 0u, 0u};
                if (t >= 0 && t < TT) raws[k] = *(const u32x4*)(a.PJ + (size_t)(b * TT + t) * NIN + 1536 + 8 * lane); }
            float win[3][8];
#pragma unroll
            for (int k = 0; k < 3; ++k) {
#pragma unroll
                for (int j = 0; j < 4; ++j) { win[k][2 * j] = __uint_as_float(raws[k][j] << 16); win[k][2 * j + 1] = __uint_as_float(raws[k][j] & 0xffff0000u); } }
#pragma unroll
            for (int i = 0; i < 8; ++i) { const u32x4 raw = raws[3 + i];
                float cur[8], o[8];
#pragma unroll
                for (int j = 0; j < 4; ++j) { cur[2 * j] = __uint_as_float(raw[j] << 16); cur[2 * j + 1] = __uint_as_float(raw[j] & 0xffff0000u); }
#pragma unroll
                for (int j = 0; j < 8; ++j) { o[j] = cb[j] + cw[0][j] * win[0][j] + cw[1][j] * win[1][j] + cw[2][j] * win[2][j] + cw[3][j] * cur[j]; win[0][j] = win[1][j]; win[1][j] = win[2][j]; win[2][j] = cur[j]; }
                u32x4 w; w.x = cvtpk(o[0], o[1]); w.y = cvtpk(o[2], o[3]); w.z = cvtpk(o[4], o[5]); w.w = cvtpk(o[6], o[7]);
                *(LAS u32x4*)(lds + (8 * wid + i) * XC_STRIDE + lane * 16) = w; }
        }
        __syncthreads();
        const int n = wid;
        rec_et(lds, a, Wr, Wi, 0, n, r32, hi, b, c, t0, nvalid, Pbrg, Pbig, Plsl);
        rec_et(lds, a, Wr, Wi, 1, n, r32, hi, b, c, t0, nvalid, Pbrg, Pbig, Plsl);
        __syncthreads();
    }
}

__device__ __forceinline__ float gelu_tanh(float x) {
    const float u = 0.7978845608028654f * (x + 0.044715f * x * x * x);
    const float e = __expf(2.0f * u);
    const float th = 1.0f - 2.0f * __builtin_amdgcn_rcpf(e + 1.0f);
    return 0.5f * x * (1.0f + th);
}
__device__ __forceinline__ void rec_fix_phase(LAS unsigned char* lds, const RecArgs& a, int bid, int G, int tid_in) {
    int tid = tid_in; asm volatile("" : "+v"(tid));
    const int lane = tid & 63, wid = __builtin_amdgcn_readfirstlane(tid >> 6);
    LAS float* Lc = (LAS float*)lds;
    for (int item = bid; item < NBATCH * NCH; item += G) {
        const int b = item < 512 ? (item >> 7) : (item - 512), c = item < 512 ? (item & 127) : 128, t0 = 64 * c, nvalid = (TT - t0) < 64 ? (TT - t0) : 64;
        float carry = 0.f;
        {
            const float* pa = a.SUMA + (size_t)(b * NCH) * 512 + tid; const float* ph = a.SUMH + (size_t)(b * NCH) * 512 + tid;
            int cc = 0;
            for (; cc + 32 <= c; cc += 32) { float A_[32], H_[32];
#pragma unroll
                for (int i = 0; i < 32; ++i) { A_[i] = pa[(size_t)(cc + i) * 512]; H_[i] = ph[(size_t)(cc + i) * 512]; }
#pragma unroll
                for (int i = 0; i < 32; ++i) carry = A_[i] * carry + H_[i]; }
            for (; cc + 8 <= c; cc += 8) { float A_[8], H_[8];
#pragma unroll
                for (int i = 0; i < 8; ++i) { A_[i] = pa[(size_t)(cc + i) * 512]; H_[i] = ph[(size_t)(cc + i) * 512]; }
#pragma unroll
                for (int i = 0; i < 8; ++i) carry = A_[i] * carry + H_[i]; }
            for (; cc < c; ++cc) carry = pa[(size_t)cc * 512] * carry + ph[(size_t)cc * 512];
        }
        Lc[tid] = carry;
        __syncthreads();
        float cv[8], gg[8];
        { const f32x4 c0 = *(const LAS f32x4*)(Lc + 8 * lane), c1 = *(const LAS f32x4*)(Lc + 8 * lane + 4);
          const f32x4 g0 = *(const f32x4*)(a.recg + 8 * lane), g1 = *(const f32x4*)(a.recg + 8 * lane + 4);
#pragma unroll
          for (int j = 0; j < 4; ++j) { cv[j] = c0[j]; cv[4 + j] = c1[j]; gg[j] = g0[j]; gg[4 + j] = g1[j]; } }
        if (8 * wid < nvalid) {
        u32x4 hls[8], cas[8], gts[8];
#pragma unroll
        for (int i = 0; i < 8; ++i) { const size_t m = (size_t)(b * TT + t0 + 8 * wid + i);
            hls[i] = *(const u32x4*)(a.HL + m * 512 + 8 * lane); cas[i] = *(const u32x4*)(a.CA + m * 512 + 8 * lane); gts[i] = *(const u32x4*)(a.PJ + m * NIN + 2048 + 8 * lane); }
#pragma unroll
        for (int i = 0; i < 8; ++i) { const int tok = 8 * wid + i;
            const size_t m = (size_t)(b * TT + t0 + tok);
            const u32x4 hl = hls[i], ca = cas[i], gt = gts[i];
            float y[8]; float ss = 0.f;
#pragma unroll
            for (int j = 0; j < 4; ++j) {
                const float h0 = __uint_as_float(hl[j] << 16) + __uint_as_float(ca[j] << 16) * cv[2 * j], h1 = __uint_as_float(hl[j] & 0xffff0000u) + __uint_as_float(ca[j] & 0xffff0000u) * cv[2 * j + 1];
                y[2 * j] = h0 * gelu_tanh(__uint_as_float(gt[j] << 16)); y[2 * j + 1] = h1 * gelu_tanh(__uint_as_float(gt[j] & 0xffff0000u));
                ss += y[2 * j] * y[2 * j] + y[2 * j + 1] * y[2 * j + 1]; }
#pragma unroll
            for (int o = 1; o < 64; o <<= 1) ss += __shfl_xor(ss, o);
            const float rn = rsqrtf(ss * (1.0f / 512.0f) + EPS);
            u32x4 w; w.x = cvtpk(y[0] * rn * gg[0], y[1] * rn * gg[1]); w.y = cvtpk(y[2] * rn * gg[2], y[3] * rn * gg[3]);
            w.z = cvtpk(y[4] * rn * gg[4], y[5] * rn * gg[5]); w.w = cvtpk(y[6] * rn * gg[6], y[7] * rn * gg[7]);
            *(u32x4*)(a.MIX + m * DM + 512 + 8 * lane) = w; }
        }
        __syncthreads();
    }
}

struct AttnArgs { const bf16_t* PJ; bf16_t* MIX; const float* subg; unsigned* ctr; float lam, shift, osc; };
constexpr int KSTR = 272, VSTR = 320, KBUF = 64 * KSTR, VBUF = 64 * VSTR, A_K0 = 0, A_V0 = 2 * KBUF, A_RING = 2 * KBUF + 3 * VBUF, SSTR = 132;
constexpr int NUNITS = 16 * NQB;

__device__ __forceinline__ void attn_phase(LAS unsigned char* lds, const AttnArgs& a, int tid_in) {
    int tid = tid_in; asm volatile("" : "+v"(tid));
    const int lane = tid & 63, wid = __builtin_amdgcn_readfirstlane(tid >> 6), r32 = lane & 31, hi = lane >> 5, rg = wid & 3, c = wid >> 2;
    LAS unsigned* sU = (LAS unsigned*)(lds + LDS_MISC);
    LAS float* LW = (LAS float*)(lds + LDS_MISC + 256) + wid * 32;
    const int skey = tid >> 4, sch = tid & 15;
    const int q4 = (lane & 15) >> 2, p4 = lane & 3, ch2 = (lane >> 4) & 1;
    const unsigned xcc = xb_xcc_id() & 7u;
    unsigned dead = 0u;
#define A_FETCH(res) do { res = 0xffffffffu; \
            for (unsigned i_ = 0; i_ < 8u && res == 0xffffffffu; ++i_) { const unsigned j_ = (xcc + i_) & 7u; \
                if (dead & (1u << j_)) continue; \
                const unsigned k_ = atomicAdd(a.ctr + 32 * j_, 1u); \
                if (k_ < 2u * NQB) res = (j_ << 8) | k_; else dead |= 1u << j_; } } while (0)
#define A_LOAD(t) do { _Pragma("unroll") for (int j_ = 0; j_ < 2; ++j_) { kreg[j_] = *(const u32x4*)(kg + (size_t)(64 * (t) + 32 * j_) * NIN); vreg[j_] = *(const u32x4*)(kg + 512 + (size_t)(64 * (t) + 32 * j_) * NIN); } } while (0)
#define A_STORE(kbi, vbi) do { _Pragma("unroll") for (int j_ = 0; j_ < 2; ++j_) { *(LAS u32x4*)(lds + A_K0 + (kbi) * KBUF + (skey + 32 * j_) * KSTR + sch * 16) = kreg[j_]; *(LAS u32x4*)(lds + A_V0 + (vbi) * VBUF + (skey + 32 * j_) * VSTR + sch * 16) = vreg[j_]; } } while (0)
#define A_UNIT_PRELOAD(U, QB, B_, H_, NT_, ROWB) do { const int qj_ = (int)((U) >> 8), qk_ = (int)((U) & 255u); \
            QB = (NQB - 1) - (qk_ >> 1); const int bh_ = 2 * qj_ + (qk_ & 1); B_ = bh_ >> 2; H_ = bh_ & 3; \
            NT_ = (2 * QB + 2) < NCH ? (2 * QB + 2) : NCH; ROWB = (size_t)B_ * TT; \
            int tp_ = tid; asm volatile("" : "+v"(tp_));       \
            const unsigned qoff_ = (unsigned)((32 * ((tp_ >> 6) & 3) + (tp_ & 31)) * NIN + (tp_ >> 8) * 64 + 8 * ((tp_ >> 5) & 1)), koff_ = (unsigned)((tp_ >> 4) * NIN + (tp_ & 15) * 8); \
            { const bf16_t* qp_ = a.PJ + ((ROWB + 128 * QB) * NIN + H_ * 128) + qoff_; \
              _Pragma("unroll") for (int d0 = 0; d0 < 4; ++d0) qr[d0] = *(const bf16x8*)(qp_ + 16 * d0); } \
            kg = a.PJ + (ROWB * NIN + 512 + H_ * 128) + koff_; \
            A_LOAD(0); } while (0)
    bf16x8 qr[4]; const bf16_t* kg; u32x4 kreg[2], vreg[2];
    int qb, b, h, NT; size_t rowb;
    {
        if (tid == 0) { unsigned res; A_FETCH(res); *sU = res; }
        __syncthreads();
        const unsigned u0 = *sU;
        __syncthreads();
        if (u0 == 0xffffffffu) return;
        A_UNIT_PRELOAD(u0, qb, b, h, NT, rowb);
    }
    for (;;) {
        A_STORE(0, 0);
        A_LOAD(1);
        __syncthreads();
        f32x16 o[4]; o[0] = f32x16{}; o[1] = f32x16{}; o[2] = f32x16{}; o[3] = f32x16{};
        float lsum = 0.f;
#define SB() __builtin_amdgcn_sched_barrier(0)
#define MF(A, B, C) __builtin_amdgcn_mfma_f32_32x32x16_bf16(A, B, C, 0, 0, 0)
#define VREAD(buf, sl) do { _Pragma("unroll") for (int db_ = 0; db_ < 4; ++db_) { \
            const s16x4 lo_ = __builtin_bit_cast(s16x4, __builtin_amdgcn_ds_read_tr16_b64_v4i16((LAS s16x4*)(vb + 16 * (sl) * VSTR + db_ * 64))); \
            const s16x4 hh_ = __builtin_bit_cast(s16x4, __builtin_amdgcn_ds_read_tr16_b64_v4i16((LAS s16x4*)(vb + (16 * (sl) + 8) * VSTR + db_ * 64))); \
            buf[db_] = (bf16x8){lo_[0], lo_[1], lo_[2], lo_[3], hh_[0], hh_[1], hh_[2], hh_[3]}; } } while (0)
#define EX4(P, B) do { P[B] = __builtin_amdgcn_exp2f(P[B]); P[B + 1] = __builtin_amdgcn_exp2f(P[B + 1]); P[B + 2] = __builtin_amdgcn_exp2f(P[B + 2]); P[B + 3] = __builtin_amdgcn_exp2f(P[B + 3]); } while (0)
#define PK4(W, P, B) do { W[0] = cvtpk(P[B], P[B + 1]); W[1] = cvtpk(P[B + 2], P[B + 3]); W[2] = cvtpk(P[B + 4], P[B + 5]); W[3] = cvtpk(P[B + 6], P[B + 7]); } while (0)
#define SUM8(P, B) do { lsum += ((P[B] + P[B + 1]) + (P[B + 2] + P[B + 3])) + ((P[B + 4] + P[B + 5]) + (P[B + 6] + P[B + 7])); } while (0)
#define AS_BF(W) __builtin_bit_cast(bf16x8, W)
#define A_QK(t) \
            const LAS unsigned char* kb = lds + A_K0 + ((t) & 1) * KBUF + r32 * KSTR + (c * 64 + 8 * hi) * 2; \
            bf16x8 kf[8]; \
            _Pragma("unroll") for (int d0 = 0; d0 < 4; ++d0) { kf[2 * d0] = *(const LAS bf16x8*)(kb + d0 * 32); kf[2 * d0 + 1] = *(const LAS bf16x8*)(kb + 32 * KSTR + d0 * 32); } \
            f32x16 p0, p1; \
            p0 = MF(kf[0], qr[0], cinit); p1 = MF(kf[1], qr[0], cinit); \
            _Pragma("unroll") for (int d0 = 1; d0 < 4; ++d0) { p0 = MF(kf[2 * d0], qr[d0], p0); p1 = MF(kf[2 * d0 + 1], qr[d0], p1); }
#define A_MASK(P, t, OFF) do { const int qrel_ = 128 * qb + 32 * rg + r32 - 64 * (t) - (OFF) - 4 * hi; _Pragma("unroll") for (int r = 0; r < 16; ++r) { if ((r & 3) + 8 * (r >> 2) > qrel_) P[r] = 0.f; } } while (0)
#define A_FIRST(MASKED, t) do { A_QK(t) \
            EX4(p0, 0); EX4(p0, 4); EX4(p0, 8); EX4(p0, 12); EX4(p1, 0); EX4(p1, 4); EX4(p1, 8); EX4(p1, 12); \
            if (MASKED) { A_MASK(p0, t, 0); A_MASK(p1, t, 32); } \
            SUM8(p0, 0); SUM8(p0, 8); SUM8(p1, 0); SUM8(p1, 8); \
            PK4(pwp0, p0, 0); PK4(pwp1, p0, 8); PK4(pwp2, p1, 0); PK4(pwp3, p1, 8); } while (0)
#define VRD1(dst, sl, db) do { \
            const s16x4 lo_ = __builtin_bit_cast(s16x4, __builtin_amdgcn_ds_read_tr16_b64_v4i16((LAS s16x4*)(vb + 16 * (sl) * VSTR + (db) * 64))); \
            const s16x4 hh_ = __builtin_bit_cast(s16x4, __builtin_amdgcn_ds_read_tr16_b64_v4i16((LAS s16x4*)(vb + (16 * (sl) + 8) * VSTR + (db) * 64))); \
            dst = (bf16x8){lo_[0], lo_[1], lo_[2], lo_[3], hh_[0], hh_[1], hh_[2], hh_[3]}; } while (0)
#define A_PIPE(MASKED, t, vslot) do { A_QK(t) \
            const LAS unsigned char* vb = lds + A_V0 + (vslot) * VBUF + (4 * hi + q4) * VSTR + (16 * ch2 + 4 * p4) * 2; \
            bf16x8 vf[4]; \
            VREAD(vf, 0); SB(); \
            __builtin_amdgcn_s_setprio(1); \
            o[0] = MF(AS_BF(pwp0), vf[0], o[0]); VRD1(vf[0], 1, 0); EX4(p0, 0); SB(); \
            o[1] = MF(AS_BF(pwp0), vf[1], o[1]); VRD1(vf[1], 1, 1); EX4(p0, 4); SB(); \
            o[2] = MF(AS_BF(pwp0), vf[2], o[2]); VRD1(vf[2], 1, 2); EX4(p0, 8); SB(); \
            o[3] = MF(AS_BF(pwp0), vf[3], o[3]); VRD1(vf[3], 1, 3); EX4(p0, 12); if (MASKED) A_MASK(p0, t, 0); SB(); \
            o[0] = MF(AS_BF(pwp1), vf[0], o[0]); VRD1(vf[0], 2, 0); EX4(p1, 0); SB(); \
            o[1] = MF(AS_BF(pwp1), vf[1], o[1]); VRD1(vf[1], 2, 1); EX4(p1, 4); SB(); \
            o[2] = MF(AS_BF(pwp1), vf[2], o[2]); VRD1(vf[2], 2, 2); EX4(p1, 8); SB(); \
            o[3] = MF(AS_BF(pwp1), vf[3], o[3]); VRD1(vf[3], 2, 3); EX4(p1, 12); if (MASKED) A_MASK(p1, t, 32); SB(); \
            o[0] = MF(AS_BF(pwp2), vf[0], o[0]); VRD1(vf[0], 3, 0); PK4(pwp0, p0, 0); SB(); \
            o[1] = MF(AS_BF(pwp2), vf[1], o[1]); VRD1(vf[1], 3, 1); PK4(pwp1, p0, 8); SB(); \
            o[2] = MF(AS_BF(pwp2), vf[2], o[2]); VRD1(vf[2], 3, 2); SB(); \
            o[3] = MF(AS_BF(pwp2), vf[3], o[3]); VRD1(vf[3], 3, 3); SB(); \
            o[0] = MF(AS_BF(pwp3), vf[0], o[0]); o[1] = MF(AS_BF(pwp3), vf[1], o[1]); o[2] = MF(AS_BF(pwp3), vf[2], o[2]); o[3] = MF(AS_BF(pwp3), vf[3], o[3]); \
            __builtin_amdgcn_s_setprio(0); \
            PK4(pwp2, p1, 0); PK4(pwp3, p1, 8); \
            SUM8(p0, 0); SUM8(p0, 8); SUM8(p1, 0); SUM8(p1, 8); } while (0)
#define A_DRAIN(vslot) do { \
            const LAS unsigned char* vb = lds + A_V0 + (vslot) * VBUF + (4 * hi + q4) * VSTR + (16 * ch2 + 4 * p4) * 2; \
            bf16x8 vf[4]; \
            VREAD(vf, 0); \
            o[0] = MF(AS_BF(pwp0), vf[0], o[0]); VRD1(vf[0], 1, 0); o[1] = MF(AS_BF(pwp0), vf[1], o[1]); VRD1(vf[1], 1, 1); o[2] = MF(AS_BF(pwp0), vf[2], o[2]); VRD1(vf[2], 1, 2); o[3] = MF(AS_BF(pwp0), vf[3], o[3]); VRD1(vf[3], 1, 3); SB(); \
            o[0] = MF(AS_BF(pwp1), vf[0], o[0]); VRD1(vf[0], 2, 0); o[1] = MF(AS_BF(pwp1), vf[1], o[1]); VRD1(vf[1], 2, 1); o[2] = MF(AS_BF(pwp1), vf[2], o[2]); VRD1(vf[2], 2, 2); o[3] = MF(AS_BF(pwp1), vf[3], o[3]); VRD1(vf[3], 2, 3); SB(); \
            o[0] = MF(AS_BF(pwp2), vf[0], o[0]); VRD1(vf[0], 3, 0); o[1] = MF(AS_BF(pwp2), vf[1], o[1]); VRD1(vf[1], 3, 1); o[2] = MF(AS_BF(pwp2), vf[2], o[2]); VRD1(vf[2], 3, 2); o[3] = MF(AS_BF(pwp2), vf[3], o[3]); VRD1(vf[3], 3, 3); SB(); \
            o[0] = MF(AS_BF(pwp3), vf[0], o[0]); o[1] = MF(AS_BF(pwp3), vf[1], o[1]); o[2] = MF(AS_BF(pwp3), vf[2], o[2]); o[3] = MF(AS_BF(pwp3), vf[3], o[3]); } while (0)
        f32x16 cinit;
#pragma unroll
        for (int r = 0; r < 16; ++r) cinit[r] = -a.shift;
        asm volatile("" : "+v"(cinit));
        asm volatile("" : "+v"(qr[0]), "+v"(qr[1]), "+v"(qr[2]), "+v"(qr[3]));
        const int NTM = (2 * qb) < NT ? (2 * qb) : NT;
        u32x4 pwp0, pwp1, pwp2, pwp3;
        if (NTM == 0) A_FIRST(true, 0); else A_FIRST(false, 0);
        A_STORE(1, 1);
        if (2 < NT) A_LOAD(2);
        __syncthreads();
        int t = 1, vp = 0, vn = 2;
        for (; t < NTM; ++t) {
            A_PIPE(false, t, vp);
            A_STORE((t + 1) & 1, vn);
            if (t + 2 < NT) A_LOAD(t + 2);
            __syncthreads();
            vp = (vp == 2) ? 0 : vp + 1; vn = (vn == 2) ? 0 : vn + 1;
        }
        for (; t < NT; ++t) {
            A_PIPE(true, t, vp);
            if (t + 1 < NT) A_STORE((t + 1) & 1, vn);
            if (t + 2 < NT) A_LOAD(t + 2);
            __syncthreads();
            vp = (vp == 2) ? 0 : vp + 1; vn = (vn == 2) ? 0 : vn + 1;
        }
        A_DRAIN(vp);
        __syncthreads();
#undef A_QK
#undef A_MASK
#undef A_FIRST
#undef A_PIPE
#undef A_DRAIN
#undef VRD1
#undef SB
#undef MF
#undef VREAD
#undef EX4
#undef PK4
#undef SUM8
#undef AS_BF
        lsum += __shfl_xor(lsum, 32);
        if (hi == 0) LW[r32] = lsum;
        asm volatile("s_waitcnt lgkmcnt(0)" ::: "memory");
        LAS float* S = (LAS float*)lds;
        float li[16];
#pragma unroll
        for (int r = 0; r < 16; ++r) li[r] = (c == 0 ? 1.0f : a.lam) / LW[(r & 3) + 8 * (r >> 2) + 4 * hi];
        if (tid == 0) { unsigned res; A_FETCH(res); *sU = res; }
        if (c == 1) {
#pragma unroll
            for (int db = 0; db < 4; ++db)
#pragma unroll
                for (int r = 0; r < 16; ++r) S[(32 * rg + (r & 3) + 8 * (r >> 2) + 4 * hi) * SSTR + 32 * db + r32] = o[db][r] * li[r];
        }
        __syncthreads();
        const unsigned un = *sU;
        int nqb = 0, nb = 0, nh = 0, nNT = 0; size_t nrowb = 0;
        if (un != 0xffffffffu) A_UNIT_PRELOAD(un, nqb, nb, nh, nNT, nrowb);
        if (c == 0) {
#pragma unroll
            for (int db = 0; db < 4; ++db)
#pragma unroll
                for (int r = 0; r < 16; ++r) { LAS float* sp = S + (32 * rg + (r & 3) + 8 * (r >> 2) + 4 * hi) * SSTR + 32 * db + r32; *sp = o[db][r] * li[r] - *sp; }
        }
        __syncthreads();
        {
            const int row = 16 * wid + (lane >> 2), qd = lane & 3, tq = 128 * qb + row;
            f32x4 v[8]; float ss = 0.f;
#pragma unroll
            for (int j = 0; j < 8; ++j) { v[j] = *(const LAS f32x4*)(S + row * SSTR + 32 * qd + 4 * j); ss += (v[j][0] * v[j][0] + v[j][1] * v[j][1]) + (v[j][2] * v[j][2] + v[j][3] * v[j][3]); }
            ss += __shfl_xor(ss, 1); ss += __shfl_xor(ss, 2);
            const float rn = rsqrtf(ss * (1.0f / 128.0f) + EPS) * a.osc;
            if (tq < TT) {
                bf16_t* op = a.MIX + (rowb + tq) * DM + h * 128 + 32 * qd;
#pragma unroll
                for (int j = 0; j < 4; ++j) { const f32x4 g0 = *(const f32x4*)(a.subg + 32 * qd + 8 * j), g1 = *(const f32x4*)(a.subg + 32 * qd + 8 * j + 4);
                    *(u32x4*)(op + 8 * j) = pack8(v[2 * j] * rn * g0, v[2 * j + 1] * rn * g1); }
            }
        }
        __syncthreads();
        if (un == 0xffffffffu) break;
        qb = nqb; b = nb; h = nh; NT = nNT; rowb = nrowb;
    }
#undef A_FETCH
#undef A_UNIT_PRELOAD
#undef A_LOAD
#undef A_STORE
}

__global__ void __launch_bounds__(512) hymba_fwd(Params p) {
    extern __shared__ __attribute__((aligned(16))) unsigned char lds_raw[];
    LAS unsigned char* lds = (LAS unsigned char*)lds_raw;
    cg::grid_group grid = cg::this_grid();
    const int tid = threadIdx.x, bid = blockIdx.x, G = gridDim.x;
    if (tid < 4) ((LAS unsigned*)(lds + LDS_MISC + 64))[tid] = 0u;
    __syncthreads();
    const XcdBarrier xbar = xcd_barrier_post((unsigned*)(p.ws + WS_CTL) + 1024, (volatile LAS unsigned*)(lds + LDS_MISC + 64));
    unsigned char* ws = p.ws;
    bf16_t* HB = (bf16_t*)(ws + WS_HB); bf16_t* PJ = (bf16_t*)(ws + WS_PJ); bf16_t* MIX = (bf16_t*)(ws + WS_MIX); bf16_t* ACT = (bf16_t*)(ws + WS_ACT);
    float* SSQ = (float*)(ws + WS_SSQ);

#ifndef NO_PRO
    prologue(p, lds, bid, G, tid);
#endif
#ifdef PROBE_SYNC10
    for (int i_ = 0; i_ < 10; ++i_) grid.sync();
#endif
#ifdef PROBE_PRO2
    __syncthreads(); prologue(p, lds, bid, G, tid);
#endif
    grid.sync();

    for (int l = 0; l < 2; ++l) {
        unsigned char* wl = ws + WS_W + (size_t)l * W_LAYER;
        {
            pg8::Gemm g{HB, (const bf16_t*)(wl + W_IN), MMAIN, NIN, DM}; pg8::StaticOrder S; S.init(MMAIN, NIN, G, bid);
            EpiIn E{PJ, SSQ, p.in[4] + l * 64, p.in[5] + l * 64};
#ifndef NO_G1
            pg8::gemm_phase<EpiIn, pg8::StaticOrder, true, true>(lds, g, S, E);
#endif
            gemm_tail<EpiIn, DM>(lds, g.A, g.Bt, g.N, E, bid, G, tid);
#ifdef PROBE_G1X2
            pg8::gemm_phase<EpiIn, pg8::StaticOrder, true, true>(lds, g, S, E);
#endif
        }
        xcd_barrier(xbar);
        RecArgs ra{PJ, (bf16_t*)(ws + WS_HL), (bf16_t*)(ws + WS_CA), (float*)(ws + WS_SUMA), (float*)(ws + WS_SUMH), MIX,
                   p.in[11] + l * 4 * 512, p.in[12] + l * 512, p.in[14] + l * 512, p.in[16] + l * 512, p.in[17] + l * 512, p.in[18] + l * 512, (const bf16_t*)(ws + WS_WG) + (size_t)l * 2 * 8 * 4096};
#ifndef NO_RECL
        rec_local_phase(lds, ra, bid, G, tid);
#endif
#ifdef PROBE_RECL2
        rec_local_phase(lds, ra, bid, G, tid);
#endif
        xcd_barrier(xbar);
#ifndef NO_RECF
        rec_fix_phase(lds, ra, bid, G, tid);
#endif
#ifdef PROBE_RECF2
        rec_fix_phase(lds, ra, bid, G, tid);
#endif
        {
            const float lam_init = (l == 0) ? 0.2f : 0.35550906759096934f;
            float d1 = 0.f, d2 = 0.f, mq = 0.f, mk = 0.f;
            for (int j = 0; j < 64; ++j) { d1 += p.in[6][l * 64 + j] * p.in[7][l * 64 + j]; d2 += p.in[8][l * 64 + j] * p.in[9][l * 64 + j];
                mq = fmaxf(mq, fabsf(p.in[4][l * 64 + j])); mk = fmaxf(mk, fabsf(p.in[5][l * 64 + j])); }
            AttnArgs aa{PJ, MIX, p.in[10] + l * 128, (unsigned*)(ws + WS_CTL) + 512 * l, __expf(d1) - __expf(d2) + lam_init, 8.0f * 1.4426950408889634f * mq * mk, 1.0f - lam_init};
#ifndef NO_ATTN
            attn_phase(lds, aa, tid);
#endif
#ifdef PROBE_ATTN2
            { AttnArgs ab = aa; ab.ctr = (unsigned*)(ws + WS_CTL) + 512 * l + 256; attn_phase(lds, ab, tid); }
#endif
        }
        xcd_barrier(xbar);
        {
            pg8::Gemm g{MIX, (const bf16_t*)(wl + W_O), MMAIN, DM, DM}; pg8::StaticOrder S; S.init(MMAIN, DM, G, bid);
            EpiRes E{p.out, HB, SSQ, 0};
#ifndef NO_G3
            pg8::gemm_phase<EpiRes, pg8::StaticOrder, true, true>(lds, g, S, E);
#endif
            gemm_tail<EpiRes, DM>(lds, g.A, g.Bt, g.N, E, bid, G, tid);
        }
        xcd_barrier(xbar);
        {
            pg8::Gemm g{HB, (const bf16_t*)(wl + W_GU), MMAIN, 2 * DFF, DM}; pg8::StaticOrder S; S.init(MMAIN, 2 * DFF, G, bid);
            EpiGU E{ACT, SSQ};
#ifndef NO_G4
            pg8::gemm_phase<EpiGU, pg8::StaticOrder, true, true>(lds, g, S, E);
#endif
            gemm_tail<EpiGU, DM>(lds, g.A, g.Bt, g.N, E, bid, G, tid);
#ifdef PROBE_G4X2
            pg8::gemm_phase<EpiGU, pg8::StaticOrder, true, true>(lds, g, S, E);
#endif
        }
        xcd_barrier(xbar);
        {
            pg8::Gemm g{ACT, (const bf16_t*)(wl + W_D), MMAIN, DM, DFF}; pg8::StaticOrder S; S.init(MMAIN, DM, G, bid);
            EpiRes E{p.out, HB, SSQ, l == 1 ? 1 : 0};
#ifndef NO_G5
            pg8::gemm_phase<EpiRes, pg8::StaticOrder, true, true>(lds, g, S, E);
#endif
            gemm_tail<EpiRes, DFF>(lds, g.A, g.Bt, g.N, E, bid, G, tid);
        }
        if (l == 0) xcd_barrier(xbar);
    }
}

extern "C" void kernel_launch(void* const* d_in, const int* in_sizes, int n_in, void* d_out, int out_size, void* d_ws, size_t ws_size, hipStream_t stream) {
    static int grid = 0;
    if (grid == 0) {
        if (n_in != 23 || ws_size < WS_END) { fprintf(stderr, "kernel_launch: unexpected inputs (n_in %d, ws %zu)\n", n_in, ws_size); grid = -1; return; }
        int dev = 0, cus = 0, per_cu = 0;
        hipGetDevice(&dev); hipDeviceGetAttribute(&cus, hipDeviceAttributeMultiprocessorCount, dev);
        if (hipFuncSetAttribute((const void*)hymba_fwd, hipFuncAttributeMaxDynamicSharedMemorySize, LDS_BYTES) != hipSuccess) { fprintf(stderr, "kernel_launch: hipFuncSetAttribute failed\n"); grid = -1; return; }
        if (hipOccupancyMaxActiveBlocksPerMultiprocessor(&per_cu, (const void*)hymba_fwd, 512, LDS_BYTES) != hipSuccess || per_cu < 1) { fprintf(stderr, "kernel_launch: occupancy query says %d\n", per_cu); per_cu = 1; }
        (void)hipGetLastError();
        grid = cus;
        if (grid > 256) grid = 256;
    }
    if (grid < 0) return;
    hipMemsetAsync((char*)d_ws + WS_CTL, 0, CTL_BYTES, stream);
    Params p{};
    for (int i = 0; i < 23; ++i) p.in[i] = (const float*)d_in[i];
    p.out = (float*)d_out; p.ws = (unsigned char*)d_ws;
    void* args[] = {&p};
    hipError_t e = hipLaunchCooperativeKernel((const void*)hymba_fwd, dim3(grid), dim3(512), args, LDS_BYTES, stream);
    if (e != hipSuccess) fprintf(stderr, "kernel_launch: cooperative launch failed: %s (grid %d)\n", hipGetErrorString(e), grid);
}
```

```cpp
#include <hip/hip_runtime.h>
#include <hip/hip_cooperative_groups.h>
#include <cstdio>
#include <cstdint>
#include <cmath>
namespace cg = cooperative_groups;
namespace pg8 {
#define PG8_LAS __attribute__((address_space(3)))
typedef unsigned short bf16_t;
typedef short bf16x8 __attribute__((ext_vector_type(8)));
typedef float f32x4 __attribute__((ext_vector_type(4)));
typedef unsigned u32x4 __attribute__((ext_vector_type(4)));
constexpr int BM = 256, BK = 64, HALF = 128, HTB = HALF * BK * 2  , STAGE_BYTES = 8 * HTB, NXCD = 8, WGM = 4;

__host__ __device__ __forceinline__ int lds_byte(int r, int c) { const int st = (r >> 4) * 2 + (c >> 5), rr = r & 15, cc = c & 31, ob = rr * 64 + cc * 2; return st * 1024 + (ob ^ (((ob >> 9) & 1) << 5)); }
__host__ __device__ __forceinline__ void stage_rc(int b, int& R, int& C) { const int st = b / 1024, sb = b % 1024, swz = sb ^ (((sb >> 9) & 1) << 5); R = (st >> 1) * 16 + swz / 64; C = (st & 1) * 32 + (swz % 64) / 2; }
__host__ __device__ __forceinline__ int perm32(int rho) { const int n = rho >> 4, i = rho & 15; return 8 * (i >> 2) + 4 * n + (i & 3); }

struct Unit { int pm, pn; };
struct Gemm { const bf16_t* A; const bf16_t* Bt; int M, N, K; };

struct StaticOrder {
    int nM, nN, nwg, G, c;
    __host__ __device__ void init(int M, int N, int G_, int c_) { nM = M / BM; nN = N / BM; nwg = nM * nN; G = G_; c = c_; }
    __host__ __device__ bool next(int i, Unit& u) const {
        const long L = (long)i * G + c; if (L >= nwg) return false;
        int wgid = (int)L; { const int q = nwg / NXCD, r = nwg % NXCD, xcd = wgid % NXCD, off = wgid / NXCD; wgid = (xcd < r ? xcd * (q + 1) : r * (q + 1) + (xcd - r) * q) + off; }
        const int nig = WGM * nN, gid = wgid / nig, fm = gid * WGM, gsz = (nM - fm) < WGM ? (nM - fm) : WGM;
        u.pm = fm + ((wgid % nig) % gsz); u.pn = (wgid % nig) / gsz; return true;
    }
    __device__ __forceinline__ void a_ready(const Unit&) const {}
    __device__ __forceinline__ void done(const Unit&) const {}
};

__device__ __forceinline__ unsigned cvt_pk_bf16(float lo, float hi) { unsigned r; asm volatile("v_cvt_pk_bf16_f32 %0, %1, %2" : "=v"(r) : "v"(lo), "v"(hi)); return r; }
typedef float f32x2 __attribute__((ext_vector_type(2)));
__device__ __forceinline__ f32x2 gelu_pk(f32x2 v) {
    const f32x2 av = __builtin_elementwise_abs(v), d = av * 0.2316418882f + 1.0f;
    f32x2 t; t.x = __builtin_amdgcn_rcpf(d.x); t.y = __builtin_amdgcn_rcpf(d.y);
    f32x2 q = t * 0.5307027145f + (-0.7265760135f); q = q * t + 0.7107068705f; q = q * t + (-0.142248368f); q = q * t + 0.127414796f; q = q * t;
    const f32x2 s = (v * v) * (-0.72134752044f);
    f32x2 e; e.x = __builtin_amdgcn_exp2f(s.x); e.y = __builtin_amdgcn_exp2f(s.y);
    const f32x2 m = v * (q * e), r = v - m;
    f32x2 o; o.x = v.x < 0.f ? m.x : r.x; o.y = v.y < 0.f ? m.y : r.y; return o;
}

template <class Epi, class Sched, bool ALIGN_EPI = false, bool SP2 = false>
__device__ __forceinline__ void gemm_phase(PG8_LAS unsigned char* lds, const Gemm g, const Sched& S, const Epi& E) {
    int tid_o = threadIdx.x; asm volatile("" : "+v"(tid_o));
    const int tid = tid_o, wid = __builtin_amdgcn_readfirstlane(tid >> 6), lane = tid & 63, wr = wid >> 2, wc = wid & 3, fr = lane & 15, fq = lane >> 4;
    const int K = g.K, nt = K / BK;
    unsigned voffA[2], voffB[2];
#pragma unroll
    for (int i = 0; i < 2; ++i) { int R, C; stage_rc(tid * 16 + i * 8192, R, C); const int Rb = Epi::PERM ? ((R & ~31) + perm32(R & 31)) : R;
        voffA[i] = (unsigned)(R * K + C) * 2u; voffB[i] = (unsigned)(Rb * K + C) * 2u; }
    const size_t kstep = (size_t)(BK * 2);
    const size_t hstep = (size_t)HALF * K * 2;
    const size_t tstep = 2 * hstep;
    const unsigned ldsw = (unsigned)wid * 1024u;
    const int aoff = lds_byte(wr * 64 + fr, fq * 8), boff = lds_byte(wc * 32 + fr, fq * 8);
#define PG8_SA(b, h) (((b) * 2 + (h)) * HTB)
#define PG8_SB(b, h) ((4 + (b) * 2 + (h)) * HTB)
#define PG8_STAGE(bufoff, gbase, voff) do { _Pragma("unroll") for (int _i = 0; _i < 2; ++_i) \
        __builtin_amdgcn_global_load_lds((const unsigned*)((const char*)(gbase) + (voff)[_i]), (PG8_LAS unsigned*)(lds + (bufoff) + ldsw + _i * 8192), 16, 0, 0); } while (0)
#define PG8_LDA(dst, b, h) do { _Pragma("unroll") for (int m = 0; m < 4; ++m) _Pragma("unroll") for (int k = 0; k < 2; ++k) dst[m][k] = *(const PG8_LAS bf16x8*)(lds + PG8_SA(b, h) + aoff + m * 2048 + k * 1024); } while (0)
#define PG8_LDB(dst, b, h) do { _Pragma("unroll") for (int n = 0; n < 2; ++n) _Pragma("unroll") for (int k = 0; k < 2; ++k) dst[n][k] = *(const PG8_LAS bf16x8*)(lds + PG8_SB(b, h) + boff + n * 2048 + k * 1024); } while (0)
#define PG8_MMA(ai, bj, At, Bt) do { __builtin_amdgcn_s_setprio(1); _Pragma("unroll") for (int m = 0; m < 4; ++m) _Pragma("unroll") for (int n = 0; n < 2; ++n) _Pragma("unroll") for (int k = 0; k < 2; ++k) \
        acc[ai][bj][m][n] = __builtin_amdgcn_mfma_f32_16x16x32_bf16(Bt[n][k], At[m][k], acc[ai][bj][m][n], 0, 0, 0); __builtin_amdgcn_s_setprio(0); } while (0)
#define PG8_WAIT_V(n) asm volatile("s_waitcnt vmcnt(" #n ")" ::: "memory")
#define PG8_WAIT_L(n) asm volatile("s_waitcnt lgkmcnt(" #n ")" ::: "memory")
#define PG8_BAR __builtin_amdgcn_s_barrier()
#define PG8_SCHED __builtin_amdgcn_sched_barrier(0)
    Unit cur, nxt; int ui = 0;
    if (!S.next(0, cur)) return;
    f32x4 acc[2][2][4][2];
#pragma unroll
    for (int a = 0; a < 2; ++a)
#pragma unroll
        for (int b = 0; b < 2; ++b)
#pragma unroll
            for (int m = 0; m < 4; ++m)
#pragma unroll
                for (int n = 0; n < 2; ++n) acc[a][b][m][n] = (f32x4){0.f, 0.f, 0.f, 0.f};
    bf16x8 At[4][2], B0[2][2], B1[2][2];
    const char* cA = (const char*)g.A + (size_t)cur.pm * tstep; const char* cB = (const char*)g.Bt + (size_t)cur.pn * tstep;
    S.a_ready(cur);
    { const auto pr0 = E.prep_issue(cur, tid); E.prep_commit(lds, pr0, 0, tid); }
    if constexpr (SP2) {
        PG8_STAGE(PG8_SB(0, 0), cB, voffB); PG8_STAGE(PG8_SB(0, 1), cB + hstep, voffB); PG8_STAGE(PG8_SA(0, 0), cA, voffA); PG8_STAGE(PG8_SA(0, 1), cA + hstep, voffA);
        if (wr == 1) PG8_BAR;
        PG8_WAIT_V(2); PG8_BAR;
        PG8_STAGE(PG8_SB(1, 0), cB + kstep, voffB); PG8_STAGE(PG8_SA(1, 0), cA + kstep, voffA); PG8_STAGE(PG8_SB(1, 1), cB + hstep + kstep, voffB);
        PG8_WAIT_V(6); PG8_BAR;
    } else {
        PG8_STAGE(PG8_SB(0, 0), cB, voffB); PG8_STAGE(PG8_SA(0, 0), cA, voffA); PG8_STAGE(PG8_SB(0, 1), cB + hstep, voffB); PG8_STAGE(PG8_SA(0, 1), cA + hstep, voffA);
        if (wr == 1) PG8_BAR;
        PG8_WAIT_V(4); PG8_BAR;
        PG8_STAGE(PG8_SB(1, 0), cB + kstep, voffB); PG8_STAGE(PG8_SA(1, 0), cA + kstep, voffA); PG8_STAGE(PG8_SB(1, 1), cB + hstep + kstep, voffB);
        PG8_WAIT_V(6); PG8_BAR;
    }
    for (;;) {
        const bool has_next = S.next(ui + 1, nxt);
        const char* nA = has_next ? (const char*)g.A + (size_t)nxt.pm * tstep : cA; const char* nB = has_next ? (const char*)g.Bt + (size_t)nxt.pn * tstep : cB;
        for (int t = 0; t < nt; t += 2) {
            const bool last = (t == nt - 2);
            const char* a1 = cA + (size_t)(t + 1) * kstep;
            const char* a2 = last ? nA : cA + (size_t)(t + 2) * kstep; const char* b2 = last ? nB : cB + (size_t)(t + 2) * kstep;
            const char* a3 = a2 + kstep; const char* b3 = b2 + kstep;
            if (last && has_next) S.a_ready(nxt);
            if constexpr (SP2) {
            PG8_LDB(B0, 0, 0); PG8_LDB(B1, 0, 1); PG8_SCHED; PG8_LDA(At, 0, 0); PG8_STAGE(PG8_SA(1, 1), a1 + hstep, voffA);
            PG8_WAIT_V(8); PG8_WAIT_L(0); PG8_BAR; PG8_MMA(0, 0, At, B0); PG8_MMA(0, 1, At, B1); PG8_BAR; PG8_SCHED;
            PG8_LDA(At, 0, 1); PG8_STAGE(PG8_SB(0, 0), b2, voffB); PG8_STAGE(PG8_SB(0, 1), b2 + hstep, voffB); PG8_STAGE(PG8_SA(0, 0), a2, voffA);
            PG8_WAIT_V(8); PG8_WAIT_L(0); PG8_BAR; PG8_MMA(1, 0, At, B0); PG8_MMA(1, 1, At, B1); PG8_BAR; PG8_SCHED;
            PG8_LDB(B0, 1, 0); PG8_LDB(B1, 1, 1); PG8_SCHED; PG8_LDA(At, 1, 0); PG8_STAGE(PG8_SA(0, 1), a2 + hstep, voffA);
            PG8_WAIT_V(8); PG8_WAIT_L(0); PG8_BAR; PG8_MMA(0, 0, At, B0); PG8_MMA(0, 1, At, B1); PG8_BAR; PG8_SCHED;
            PG8_LDA(At, 1, 1); PG8_STAGE(PG8_SB(1, 0), b3, voffB); PG8_STAGE(PG8_SB(1, 1), b3 + hstep, voffB); PG8_STAGE(PG8_SA(1, 0), a3, voffA);
            PG8_WAIT_V(8); PG8_WAIT_L(0); PG8_BAR; PG8_MMA(1, 0, At, B0); PG8_MMA(1, 1, At, B1); PG8_BAR; PG8_SCHED;
            } else {
            PG8_LDB(B0, 0, 0); PG8_SCHED; PG8_LDA(At, 0, 0); PG8_STAGE(PG8_SA(1, 1), a1 + hstep, voffA);
            PG8_WAIT_L(8); PG8_BAR; PG8_WAIT_L(0); PG8_MMA(0, 0, At, B0); PG8_BAR; PG8_SCHED;
            PG8_LDB(B1, 0, 1); PG8_STAGE(PG8_SB(0, 0), b2, voffB);
            PG8_BAR; PG8_WAIT_L(0); PG8_MMA(0, 1, At, B1); PG8_BAR;
            PG8_LDA(At, 0, 1); PG8_STAGE(PG8_SA(0, 0), a2, voffA);
            PG8_BAR; PG8_WAIT_L(0); PG8_MMA(1, 0, At, B0); PG8_BAR; PG8_SCHED;
            PG8_STAGE(PG8_SB(0, 1), b2 + hstep, voffB);
            PG8_WAIT_V(6); PG8_BAR; PG8_MMA(1, 1, At, B1); PG8_BAR;
            PG8_LDB(B0, 1, 0); PG8_SCHED; PG8_LDA(At, 1, 0); PG8_STAGE(PG8_SA(0, 1), a2 + hstep, voffA);
            PG8_WAIT_L(8); PG8_BAR; PG8_WAIT_L(0); PG8_MMA(0, 0, At, B0); PG8_BAR; PG8_SCHED;
            PG8_LDB(B1, 1, 1); PG8_STAGE(PG8_SB(1, 0), b3, voffB);
            PG8_BAR; PG8_WAIT_L(0); PG8_MMA(0, 1, At, B1); PG8_BAR;
            PG8_LDA(At, 1, 1); PG8_STAGE(PG8_SA(1, 0), a3, voffA);
            PG8_BAR; PG8_WAIT_L(0); PG8_MMA(1, 0, At, B0); PG8_BAR; PG8_SCHED;
            PG8_STAGE(PG8_SB(1, 1), b3 + hstep, voffB);
            PG8_WAIT_V(6); PG8_BAR; PG8_MMA(1, 1, At, B1); PG8_BAR;
            }
        }
        if constexpr (ALIGN_EPI) { if (wr == 0) PG8_BAR; }
        if constexpr (!Epi::AFTER_DRAIN) { const auto pr = E.prep_issue(has_next ? nxt : cur, tid); E.run(acc, cur, wr, wc, fr, fq, 2, lds, ui); E.prep_commit(lds, pr, ui + 1, tid); S.done(cur); }
#ifdef PROBE_EPI2
        if constexpr (Epi::IDEMP) { E.run(acc, cur, wr, wc, fr, fq, 2, lds, ui); }
#endif
        if (!has_next) break;
#pragma unroll
        for (int a = 0; a < 2; ++a)
#pragma unroll
            for (int b = 0; b < 2; ++b)
#pragma unroll
                for (int m = 0; m < 4; ++m)
#pragma unroll
                    for (int n = 0; n < 2; ++n) acc[a][b][m][n] = (f32x4){0.f, 0.f, 0.f, 0.f};
        cur = nxt; cA = nA; cB = nB; ++ui;
        if constexpr (ALIGN_EPI) { if (wr == 1) PG8_BAR; }
    }
    PG8_WAIT_V(0);
    if constexpr (!ALIGN_EPI) { if (wr == 0) PG8_BAR; }
    PG8_BAR;
    if constexpr (Epi::AFTER_DRAIN) { E.fused(acc, cur, wr, wc, fr, fq, lds, wid, lane); S.done(cur); }
#undef PG8_SA
#undef PG8_SB
#undef PG8_STAGE
#undef PG8_LDA
#undef PG8_LDB
#undef PG8_MMA
#undef PG8_WAIT_V
#undef PG8_WAIT_L
#undef PG8_BAR
#undef PG8_SCHED
}
}

using pg8::bf16_t; using pg8::bf16x8; using pg8::f32x4; using pg8::u32x4; using pg8::Unit;
typedef float f32x16 __attribute__((ext_vector_type(16)));
typedef short s16x4 __attribute__((ext_vector_type(4)));
typedef unsigned u32x2 __attribute__((ext_vector_type(2)));
#define LAS __attribute__((address_space(3)))
#define XB_TMO      128
#define XB_XCNT(j)  (256  + 64 * (j))
#define XB_XSUB(j)  (1280 + 64 * (j))
#define XB_XGEN(j)  (2304 + 64 * (j))
#define XB_TOP      3328
#define XB_TOPGEN   3392
#define XCD_BAR_WORDS 3456
#define XB_SPIN_CAP (1u << 18)

__device__ __forceinline__ unsigned xb_ld(unsigned* p)              { return __hip_atomic_load(p, __ATOMIC_RELAXED, __HIP_MEMORY_SCOPE_AGENT); }
__device__ __forceinline__ unsigned xb_add(unsigned* p, unsigned v) { return __hip_atomic_fetch_add(p, v, __ATOMIC_RELAXED, __HIP_MEMORY_SCOPE_AGENT); }
__device__ __forceinline__ unsigned xb_xcc_id() { return (unsigned)__builtin_amdgcn_s_getreg((3 << 11) | 20) & 0xFu; }
#define XB_SPIN(cond, bar) do { unsigned _sp = 0; while (cond) { __builtin_amdgcn_s_sleep(1); \
    if ((++_sp & 255u) == 0u) { if (xb_ld(&(bar)[XB_TMO])) break; if (_sp > XB_SPIN_CAP) { atomicAdd(&(bar)[XB_TMO], 1u); break; } } } } while (0)

struct XcdBarrier {
    unsigned* bar; unsigned x;
    volatile LAS unsigned* st;
};

__device__ __forceinline__ XcdBarrier xcd_barrier_post(unsigned* bar, volatile LAS unsigned* st) {
    XcdBarrier b; b.bar = bar; b.x = xb_xcc_id(); b.st = st;
    if (threadIdx.x == 0) (void)xb_add(&bar[XB_XCNT(b.x)], 1u);
    return b;
}
__device__ __forceinline__ void xcd_barrier_complete(unsigned* bar, unsigned x, unsigned& nloc, unsigned& nx) {
    const unsigned G = gridDim.x * gridDim.y * gridDim.z;
    unsigned sum, cnt, mine, sp = 0u;
    for (;;) {
        sum = 0u; cnt = 0u; mine = 0u;
#pragma unroll
        for (unsigned j = 0; j < 16; ++j) { const unsigned c = xb_ld(&bar[XB_XCNT(j)]); sum += c; cnt += (c > 0u) ? 1u : 0u; mine = (j == x) ? c : mine; }
        if (sum == G) break;
        __builtin_amdgcn_s_sleep(1);
        if ((++sp & 255u) == 0u) { if (xb_ld(&bar[XB_TMO])) break; if (sp > XB_SPIN_CAP) { atomicAdd(&bar[XB_TMO], 1u); break; } }
    }
    nloc = mine > 0u ? mine : 1u; nx = cnt > 0u ? cnt : 1u;
}

__device__ __forceinline__ void xcd_barrier(const XcdBarrier& b) {
    asm volatile("s_waitcnt vmcnt(0)" ::: "memory");
    __syncthreads();
    if (threadIdx.x == 0) {
        unsigned* bar = b.bar;
        __builtin_amdgcn_s_waitcnt(0);
        unsigned nloc = b.st[0], nx = b.st[1];
        if (nloc == 0u) { xcd_barrier_complete(bar, b.x, nloc, nx); b.st[0] = nloc; b.st[1] = nx; }
        const unsigned old = xb_add(&bar[XB_XSUB(b.x)], 1u);
        const unsigned gen = old / nloc;
        if (old + 1u == (gen + 1u) * nloc) {
            __builtin_amdgcn_fence(__ATOMIC_RELEASE, "agent");
            asm volatile("s_waitcnt vmcnt(0)" ::: "memory");
            const unsigned og = xb_add(&bar[XB_TOP], 1u);
            const unsigned tg = og / nx;
            if (og + 1u == (tg + 1u) * nx) xb_add(&bar[XB_TOPGEN], 1u);
            else XB_SPIN(xb_ld(&bar[XB_TOPGEN]) == tg, bar);
            __builtin_amdgcn_fence(__ATOMIC_ACQUIRE, "agent");
            xb_add(&bar[XB_XGEN(b.x)], 1u);
            asm volatile("s_waitcnt vmcnt(0)" ::: "memory");
        } else {
            XB_SPIN(xb_ld(&bar[XB_XGEN(b.x)]) == gen, bar);
            __builtin_amdgcn_fence(__ATOMIC_ACQUIRE, "agent");
            asm volatile("s_waitcnt vmcnt(0)" ::: "memory");
        }
    }
    __syncthreads();
}


constexpr int DM = 1024, TT = 8208, NBATCH = 4, MROWS = NBATCH * TT, MP = 33024, NIN = 2560, DFF = 2816, SEQ = 8192;
constexpr int NCH = 129;
constexpr int NQB = 65;
constexpr float EPS = 1e-6f;
__device__ constexpr float ROPE_INV[8] = {1.0f, 0.1939227432012558f, 0.03760603070259094f, 0.007292664609849453f, 0.0014142135623842478f, 0.00027424818836152554f, 5.318296098266728e-05f, 1.0313386155758053e-05f};
constexpr float C2 = 0.125f * 1.4426950408889634f;
constexpr size_t MiB = 1u << 20;
constexpr size_t WS_CTL = 0, CTL_BYTES = 32768;
constexpr size_t WS_W = 2 * MiB, W_LAYER = 24 * MiB, W_IN = 0, W_O = 5 * MiB, W_GU = 7 * MiB, W_D = 18 * MiB;
constexpr size_t WS_ROPE = 50 * MiB, WS_SSQ = 52 * MiB, WS_SUMA = 55 * MiB, WS_SUMH = 57 * MiB, WS_HM = 59 * MiB, WS_WG = 60 * MiB;
constexpr size_t WS_HB = 64 * MiB, WS_PJ = 130 * MiB, WS_HL = 292 * MiB, WS_CA = 325 * MiB, WS_MIX = 358 * MiB, WS_ACT = 130 * MiB, WS_END = 423 * MiB;
constexpr int LDS_BYTES = 147456, LDS_MISC = 139264;

typedef float f32x2_t __attribute__((ext_vector_type(2))); typedef __bf16 bf16x2_t __attribute__((ext_vector_type(2)));
__device__ __forceinline__ unsigned cvtpk(float lo, float hi) { f32x2_t v = {lo, hi}; bf16x2_t b = __builtin_convertvector(v, bf16x2_t); return __builtin_bit_cast(unsigned, b); }
__device__ __forceinline__ void row_bt(int r, int& b, int& t) { b = r / TT; t = r - b * TT; }
__device__ __forceinline__ float bf2f(unsigned short v) { return __uint_as_float((unsigned)v << 16); }
__device__ __forceinline__ u32x4 pack8(const f32x4 a, const f32x4 b) { u32x4 w; w.x = cvtpk(a[0], a[1]); w.y = cvtpk(a[2], a[3]); w.z = cvtpk(b[0], b[1]); w.w = cvtpk(b[2], b[3]); return w; }
__device__ __forceinline__ float row_rs(const float* SSQ, int r) {
    const f32x4* sp = (const f32x4*)(SSQ + (size_t)r * 16); const f32x4 a = sp[0], b = sp[1], c = sp[2], d = sp[3];
    const f32x4 s = (a + b) + (c + d); return rsqrtf(((s[0] + s[1]) + (s[2] + s[3])) * (1.0f / DM) + EPS);
}


constexpr int LDS_RSTAB = LDS_MISC + 2048;
struct PrepRegs { f32x4 a, b; };
__device__ __forceinline__ PrepRegs rs_issue(const float* SSQ, const Unit& u, int tid) { const f32x4* sp = (const f32x4*)(SSQ + (size_t)(u.pm * 256 + (tid >> 1)) * 16 + 8 * (tid & 1)); PrepRegs r; r.a = sp[0]; r.b = sp[1]; return r; }
__device__ __forceinline__ void rs_commit(LAS unsigned char* lds, const PrepRegs& r, int ui, int tid) {
    const f32x4 s4 = r.a + r.b; float s = (s4[0] + s4[1]) + (s4[2] + s4[3]); s += __shfl_xor(s, 1);
    if ((tid & 1) == 0) ((LAS float*)(lds + LDS_RSTAB))[(ui & 1) * 256 + (tid >> 1)] = rsqrtf(s * (1.0f / DM) + EPS);
}
struct EpiIn {
    static constexpr bool PERM = true, AFTER_DRAIN = false, IDEMP = true;
    bf16_t* PJ; const float* SSQ; const float* gq; const float* gk;
    __device__ __forceinline__ PrepRegs prep_issue(const Unit& u, int tid) const { return rs_issue(SSQ, u, tid); }
    __device__ __forceinline__ void prep_commit(LAS unsigned char* lds, const PrepRegs& r, int ui, int tid) const { rs_commit(lds, r, ui, tid); }
    __device__ __forceinline__ void run(const f32x4 (&acc)[2][2][4][2], const Unit& u, int wr, int wc, int fr, int fq, const int nai, LAS unsigned char* lds, const int ui) const {
        const LAS float* RT = (const LAS float*)(lds + LDS_RSTAB) + (ui & 1) * 256;
        const int pn = u.pn; const bool isqk = pn < 4;
        f32x4 gv[2][2];
#pragma unroll
        for (int bj = 0; bj < 2; ++bj)
#pragma unroll
            for (int n = 0; n < 2; ++n) gv[bj][n] = isqk ? *(const f32x4*)((pn < 2 ? gq : gk) + 32 * bj + 8 * fq + 4 * n) : (f32x4){1.f, 1.f, 1.f, 1.f};
        const float qs = (pn < 2) ? C2 : 1.f;
#pragma unroll
        for (int ai = 0; ai < nai; ++ai)
#pragma unroll
            for (int m = 0; m < 4; ++m) {
                const int r = u.pm * 256 + ai * 128 + wr * 64 + m * 16 + fr;
                const float rs = RT[ai * 128 + wr * 64 + m * 16 + fr];
                f32x4 v[2][2];
#pragma unroll
                for (int bj = 0; bj < 2; ++bj)
#pragma unroll
                    for (int n = 0; n < 2; ++n) v[bj][n] = acc[ai][bj][m][n] * rs;
                if (isqk) {
                    float q2 = 0.f;
#pragma unroll
                    for (int bj = 0; bj < 2; ++bj)
#pragma unroll
                        for (int n = 0; n < 2; ++n) { const f32x4 x = v[bj][n]; q2 += (x[0] * x[0] + x[1] * x[1]) + (x[2] * x[2] + x[3] * x[3]); }
                    q2 += __shfl_xor(q2, 16); q2 += __shfl_xor(q2, 32);
                    const float rn = rsqrtf(q2 * (1.0f / 64.0f) + EPS);
#pragma unroll
                    for (int bj = 0; bj < 2; ++bj)
#pragma unroll
                        for (int n = 0; n < 2; ++n) v[bj][n] = v[bj][n] * rn * gv[bj][n];
                    int b, t; row_bt(r, b, t);
#pragma unroll
                    for (int n = 0; n < 2; ++n) {
                        f32x4 o; o[0] = __shfl_xor(v[0][n][0], 16); o[1] = __shfl_xor(v[0][n][1], 16); o[2] = __shfl_xor(v[0][n][2], 16); o[3] = __shfl_xor(v[0][n][3], 16);
                        f32x4 c, s;
#pragma unroll
                        for (int i = 0; i < 4; ++i) {
                            const float angf = (float)t * ROPE_INV[4 * n + i];
                            const float pr_ = angf * 0.15915494f, er_ = __builtin_fmaf(angf, 0.15915494f, -pr_);
                            const float rev = __builtin_amdgcn_fractf(pr_) + __builtin_fmaf(angf, (float)(0.15915494309189535 - (double)0.15915494f), er_);
                            c[i] = __builtin_amdgcn_cosf(rev); s[i] = __builtin_amdgcn_sinf(rev); }
                        v[0][n] = (fq == 0) ? (v[0][n] * c - o * s) : ((fq == 1) ? (v[0][n] * c + o * s) : v[0][n]);
                    }
#pragma unroll
                    for (int bj = 0; bj < 2; ++bj)
#pragma unroll
                        for (int n = 0; n < 2; ++n) v[bj][n] = v[bj][n] * qs;
                }
                bf16_t* rowp = PJ + (size_t)r * NIN + pn * 256 + wc * 64 + 8 * fq;
#pragma unroll
                for (int bj = 0; bj < 2; ++bj) *(u32x4*)(rowp + 32 * bj) = pack8(v[bj][0], v[bj][1]);
            }
    }
};

struct EpiRes {
    static constexpr bool PERM = true, AFTER_DRAIN = false, IDEMP = false;
    float* out; bf16_t* HB; float* SSQ; int final;
    __device__ __forceinline__ void operator()(const f32x4 (&acc)[2][2][4][2], const Unit& u, int wr, int wc, int fr, int fq) const { run(acc, u, wr, wc, fr, fq, 2, nullptr, 0); }
    __device__ __forceinline__ int prep_issue(const Unit&, int) const { return 0; }
    __device__ __forceinline__ void prep_commit(LAS unsigned char*, int, int, int) const {}
    __device__ __forceinline__ void run(const f32x4 (&acc)[2][2][4][2], const Unit& u, int wr, int wc, int fr, int fq, const int nai, LAS unsigned char* lds, const int ui) const {
        const int pn = u.pn, col = pn * 256 + wc * 64 + 8 * fq;
#pragma unroll
        for (int ai = 0; ai < nai; ++ai) {
            if (u.pm * 256 + ai * 128 + wr * 64 >= MROWS) continue;
            u32x4 pre[4][2];
#pragma unroll
            for (int m = 0; m < 4; ++m) {
                const int r = u.pm * 256 + ai * 128 + wr * 64 + m * 16 + fr;
#pragma unroll
                for (int bj = 0; bj < 2; ++bj) pre[m][bj] = *(const u32x4*)(HB + (size_t)r * DM + col + 32 * bj);
            }
#pragma unroll
            for (int m = 0; m < 4; ++m) {
                const int r = u.pm * 256 + ai * 128 + wr * 64 + m * 16 + fr;
                int b, t; row_bt(r, b, t);
                float ss = 0.f;
#pragma unroll
                for (int bj = 0; bj < 2; ++bj) {
                    const u32x4 pw = pre[m][bj];
                    const f32x4 b0 = {__uint_as_float(pw[0] << 16), __uint_as_float(pw[0] & 0xffff0000u), __uint_as_float(pw[1] << 16), __uint_as_float(pw[1] & 0xffff0000u)};
                    const f32x4 b1 = {__uint_as_float(pw[2] << 16), __uint_as_float(pw[2] & 0xffff0000u), __uint_as_float(pw[3] << 16), __uint_as_float(pw[3] & 0xffff0000u)};
                    const f32x4 h0 = b0 + acc[ai][bj][m][0], h1 = b1 + acc[ai][bj][m][1];
                    if (final) { if (t >= 16) { float* op = out + (size_t)(b * SEQ + t - 16) * DM + col + 32 * bj; *(f32x4*)op = h0; *(f32x4*)(op + 4) = h1; } }
                    else {
                        ss += (h0[0] * h0[0] + h0[1] * h0[1]) + (h0[2] * h0[2] + h0[3] * h0[3]) + (h1[0] * h1[0] + h1[1] * h1[1]) + (h1[2] * h1[2] + h1[3] * h1[3]);
                        *(u32x4*)(HB + (size_t)r * DM + col + 32 * bj) = pack8(h0, h1); }
                }
                if (!final) { ss += __shfl_xor(ss, 16); ss += __shfl_xor(ss, 32); if (fq == 0) SSQ[(size_t)r * 16 + pn * 4 + wc] = ss; }
            }
        }
    }
};

struct EpiGU {
    static constexpr bool PERM = true, AFTER_DRAIN = false, IDEMP = true;
    bf16_t* ACT; const float* SSQ;
    __device__ __forceinline__ PrepRegs prep_issue(const Unit& u, int tid) const { return rs_issue(SSQ, u, tid); }
    __device__ __forceinline__ void prep_commit(LAS unsigned char* lds, const PrepRegs& r, int ui, int tid) const { rs_commit(lds, r, ui, tid); }
    __device__ __forceinline__ void run(const f32x4 (&acc)[2][2][4][2], const Unit& u, int wr, int wc, int fr, int fq, const int nai, LAS unsigned char* lds, const int ui) const {
        const LAS float* RT = (const LAS float*)(lds + LDS_RSTAB) + (ui & 1) * 256;
#pragma unroll
        for (int ai = 0; ai < nai; ++ai)
#pragma unroll
            for (int m = 0; m < 4; ++m) {
                const int r = u.pm * 256 + ai * 128 + wr * 64 + m * 16 + fr;
                const float rs = RT[ai * 128 + wr * 64 + m * 16 + fr];
                f32x4 a[2];
#pragma unroll
                for (int n = 0; n < 2; ++n) {
                    const f32x4 g = acc[ai][0][m][n] * rs, uu = acc[ai][1][m][n] * rs;
#pragma unroll
                    for (int i = 0; i < 4; ++i) a[n][i] = g[i] * uu[i] * __builtin_amdgcn_rcpf(1.0f + __expf(-g[i]));
                }
                *(u32x4*)(ACT + (size_t)r * DFF + u.pn * 128 + wc * 32 + 8 * fq) = pack8(a[0], a[1]);
            }
    }
};


constexpr int MMAIN = 32768;
template <class Epi, int K>
__device__ __forceinline__ void gemm_tail(LAS unsigned char* lds, const bf16_t* A, const bf16_t* Bt, const int N, const Epi& E, const int bid, const int G, const int tid_in) {
    int tid = tid_in; asm volatile("" : "+v"(tid));
    const int lane = tid & 63, wid = __builtin_amdgcn_readfirstlane(tid >> 6), i16 = lane & 15, kq = lane >> 4;
    constexpr int kw = K / 8, NS = kw / 32;
    const int nItems = (N >> 8) * 4;
    for (int item = bid; item < nItems; item += G) {
        const int pn = item >> 2, wc = item & 3;
        Unit ut; ut.pm = MMAIN / 256; ut.pn = pn;
        const auto prt = E.prep_issue(ut, tid);
        const bf16_t* ap = A + (size_t)(MMAIN + i16) * K + wid * kw + 8 * kq;
        const bf16_t* bp = Bt + (size_t)(256 * pn + 32 * wc + 8 * (i16 >> 2) + (i16 & 3)) * K + wid * kw + 8 * kq;
        f32x4 acc[2][4][2];
#pragma unroll
        for (int bj = 0; bj < 2; ++bj)
#pragma unroll
            for (int m = 0; m < 4; ++m)
#pragma unroll
                for (int n = 0; n < 2; ++n) acc[bj][m][n] = (f32x4){0.f, 0.f, 0.f, 0.f};
#pragma unroll
        for (int sb = 0; sb < NS; sb += 4) {
            bf16x8 af[4][4], bf[4][2][2];
#pragma unroll
            for (int s = 0; s < 4; ++s) if (sb + s < NS) {
#pragma unroll
                for (int m = 0; m < 4; ++m) af[s][m] = *(const bf16x8*)(ap + (size_t)(16 * m) * K + 32 * (sb + s));
#pragma unroll
                for (int bj = 0; bj < 2; ++bj)
#pragma unroll
                    for (int n = 0; n < 2; ++n) bf[s][bj][n] = *(const bf16x8*)(bp + (size_t)(128 * bj + 4 * n) * K + 32 * (sb + s));
            }
#pragma unroll
            for (int s = 0; s < 4; ++s) if (sb + s < NS) {
#pragma unroll
                for (int bj = 0; bj < 2; ++bj)
#pragma unroll
                    for (int m = 0; m < 4; ++m)
#pragma unroll
                        for (int n = 0; n < 2; ++n) acc[bj][m][n] = __builtin_amdgcn_mfma_f32_16x16x32_bf16(bf[s][bj][n], af[s][m], acc[bj][m][n], 0, 0, 0);
            }
        }
        E.prep_commit(lds, prt, 0, tid);
        LAS f32x4* P = (LAS f32x4*)lds;
#pragma unroll
        for (int bj = 0; bj < 2; ++bj)
#pragma unroll
            for (int m = 0; m < 4; ++m)
#pragma unroll
                for (int n = 0; n < 2; ++n) P[(wid * 16 + bj * 8 + m * 2 + n) * 64 + lane] = acc[bj][m][n];
        __syncthreads();
        if (wid == 0) {
            f32x4 full[2][2][4][2];
#pragma unroll
            for (int bj = 0; bj < 2; ++bj)
#pragma unroll
                for (int m = 0; m < 4; ++m)
#pragma unroll
                    for (int n = 0; n < 2; ++n) { full[0][bj][m][n] = acc[bj][m][n]; full[1][bj][m][n] = (f32x4){0.f, 0.f, 0.f, 0.f}; }
#pragma unroll 1
            for (int w = 1; w < 8; ++w) {
#pragma unroll
                for (int bj = 0; bj < 2; ++bj)
#pragma unroll
                    for (int m = 0; m < 4; ++m)
#pragma unroll
                        for (int n = 0; n < 2; ++n) full[0][bj][m][n] += P[(w * 16 + bj * 8 + m * 2 + n) * 64 + lane];
                asm volatile("" ::: "memory");
            }
            Unit u; u.pm = MMAIN / 256; u.pn = pn;
            E.run(full, u, 0, wc, lane & 15, lane >> 4, 1, lds, 0);
        }
        __syncthreads();
    }
}
__device__ __forceinline__ unsigned f2bf(float f) { unsigned u = __float_as_uint(f); return (u + 0x7fffu + ((u >> 16) & 1u)) >> 16; }
__device__ __forceinline__ unsigned pk2(float lo, float hi) { return f2bf(lo) | (f2bf(hi) << 16); }
__device__ __forceinline__ void transpose_item(const float* W, int K, int Nsrc, bf16_t* WT, int n0, int src_col0, int k0, const float* gk, LAS float* scr, int lane) {
    float wv[32];
#pragma unroll
    for (int i = 0; i < 32; ++i) wv[i] = W[(size_t)(k0 + 2 * i + (lane >> 5)) * Nsrc + src_col0 + (lane & 31)];
#pragma unroll
    for (int i = 0; i < 32; ++i) { const int kk = 2 * i + (lane >> 5); float v = wv[i]; if (gk) v *= gk[k0 + kk]; scr[kk * 33 + (lane & 31)] = v; }
    asm volatile("s_waitcnt lgkmcnt(0)" ::: "memory");
    const int c = lane & 7;
#pragma unroll
    for (int j = 0; j < 4; ++j) { const int n = (lane >> 3) + 8 * j; const LAS float* s = scr + (8 * c) * 33 + n;
        u32x4 o; o.x = pk2(s[0 * 33], s[1 * 33]); o.y = pk2(s[2 * 33], s[3 * 33]); o.z = pk2(s[4 * 33], s[5 * 33]); o.w = pk2(s[6 * 33], s[7 * 33]);
        *(u32x4*)(WT + (size_t)(n0 + n) * K + k0 + 8 * c) = o; }
    asm volatile("s_waitcnt lgkmcnt(0)" ::: "memory");
}
__device__ __forceinline__ int perm_src(int n0) { const int pn = n0 >> 8, rem = n0 & 255, bj = rem >> 7, wc = (rem >> 5) & 3; return pn * 256 + wc * 64 + bj * 32; }
__device__ __forceinline__ int gu_src(int n0) { const int pn = n0 >> 8, rem = n0 & 255, bj = rem >> 7, wc = (rem >> 5) & 3; return bj * DFF + pn * 128 + wc * 32; }

struct Params { const float* in[23]; float* out; unsigned char* ws; };

__device__ __forceinline__ void prologue(const Params& p, LAS unsigned char* lds, int bid, int G, int tid_in) {
    int tid = tid_in; asm volatile("" : "+v"(tid));
    const int lane = tid & 63, wave = tid >> 6;
    LAS float* scr = (LAS float*)(lds + wave * 16384);
    const int gw = bid * 8 + wave, NGW = G * 8;
    constexpr int I_IN = 16 * 80, I_O = 16 * 32, I_GU = 16 * 176, I_D = 44 * 32, I_L = I_IN + I_O + I_GU + I_D;
    for (int it = gw; it < 2 * I_L; it += NGW) {
        const int l = it / I_L; int r = it - l * I_L;
        unsigned char* wl = p.ws + WS_W + (size_t)l * W_LAYER;
        if (r < I_IN) { const int kb = r / 80, nb = r % 80; transpose_item(p.in[3] + (size_t)l * DM * NIN, DM, NIN, (bf16_t*)(wl + W_IN), 32 * nb, perm_src(32 * nb), 64 * kb, p.in[2] + l * DM, scr, lane); continue; } r -= I_IN;
        if (r < I_O) { const int kb = r / 32, nb = r % 32; transpose_item(p.in[19] + (size_t)l * DM * DM, DM, DM, (bf16_t*)(wl + W_O), 32 * nb, perm_src(32 * nb), 64 * kb, nullptr, scr, lane); continue; } r -= I_O;
        if (r < I_GU) { const int kb = r / 176, nb = r % 176; transpose_item(p.in[21] + (size_t)l * DM * 2 * DFF, DM, 2 * DFF, (bf16_t*)(wl + W_GU), 32 * nb, gu_src(32 * nb), 64 * kb, p.in[20] + l * DM, scr, lane); continue; } r -= I_GU;
        { const int kb = r / 32, nb = r % 32; transpose_item(p.in[22] + (size_t)l * DFF * DM, DFF, DM, (bf16_t*)(wl + W_D), 32 * nb, perm_src(32 * nb), 64 * kb, nullptr, scr, lane); }
    }
    bf16_t* HB = (bf16_t*)(p.ws + WS_HB); float* SSQ = (float*)(p.ws + WS_SSQ); bf16_t* MIX = (bf16_t*)(p.ws + WS_MIX);
    for (int m0 = gw; m0 < MP; m0 += 2 * NGW) {
        f32x4 v[2][4];
#pragma unroll
        for (int q = 0; q < 2; ++q) { const int m = m0 + q * NGW;
            if (m < MROWS) { int b, t; row_bt(m, b, t);
                const f32x4* xr = (const f32x4*)(t < 16 ? p.in[1] + (size_t)t * DM : p.in[0] + (size_t)(b * SEQ + t - 16) * DM) + lane;
#pragma unroll
                for (int j = 0; j < 4; ++j) v[q][j] = xr[64 * j];
            } else {
#pragma unroll
                for (int j = 0; j < 4; ++j) v[q][j] = (f32x4){0.f, 0.f, 0.f, 0.f};
            } }
#pragma unroll
        for (int q = 0; q < 2; ++q) { const int m = m0 + q * NGW; if (m >= MP) continue;
            float s = 0.f;
#pragma unroll
            for (int j = 0; j < 4; ++j) s += (v[q][j][0] * v[q][j][0] + v[q][j][1] * v[q][j][1]) + (v[q][j][2] * v[q][j][2] + v[q][j][3] * v[q][j][3]);
            if (m >= MROWS) { u32x2* mo = (u32x2*)(MIX + (size_t)m * DM) + lane;
#pragma unroll
                for (int j = 0; j < 4; ++j) mo[64 * j] = (u32x2){0u, 0u}; }
#pragma unroll
            for (int o = 1; o < 64; o <<= 1) s += __shfl_xor(s, o);
            u32x2* ho = (u32x2*)(HB + (size_t)m * DM) + lane;
#pragma unroll
            for (int j = 0; j < 4; ++j) ho[64 * j] = (u32x2){cvtpk(v[q][j][0], v[q][j][1]), cvtpk(v[q][j][2], v[q][j][3])};
            if (lane < 16) SSQ[(size_t)m * 16 + lane] = (lane == 0) ? s : 0.f; }
    }
    { bf16_t* WG = (bf16_t*)(p.ws + WS_WG);
      for (int idx = bid * 512 + tid; idx < 2 * 2 * 8 * 4096; idx += G * 512) { const int d = idx & 63, e = (idx >> 6) & 63, n = (idx >> 12) & 7, g = (idx >> 15) & 1, l = idx >> 16;
          WG[idx] = (bf16_t)f2bf(p.in[g == 0 ? 13 : 15][(size_t)((l * 8 + n) * 64 + d) * 64 + e]); } }
}

struct RecArgs { const bf16_t* PJ; bf16_t* HL; bf16_t* CA; float* SUMA; float* SUMH; bf16_t* MIX;
                 const float *conv_w, *conv_b, *b_rg, *b_ig, *lruL, *recg; const bf16_t* wgt; };
constexpr int XC_STRIDE = 1040;

__device__ __forceinline__ void rec_et(LAS unsigned char* lds, const RecArgs& a, const bf16_t* Wr, const bf16_t* Wi, const int et, const int n, const int r32, const int hi,
                                       const int b, const int c, const int t0, const int nvalid, LAS float* Pbrg, LAS float* Pbig, LAS float* Plsl) {
            float A0[16], H0[16];
#pragma unroll
            for (int r = 0; r < 16; ++r) { A0[r] = 1.0f; H0[r] = 0.f; }
            const int ntt = nvalid > 32 ? 2 : 1;
#pragma unroll 1
            for (int tt = 0; tt < ntt; ++tt) {
                f32x16 accr = {}, acci = {};
#pragma unroll
                for (int kk = 0; kk < 4; ++kk) { const bf16x8 xb = *(const LAS bf16x8*)(lds + (32 * tt + r32) * XC_STRIDE + (64 * n + 16 * kk + 8 * hi) * 2);
                    const bf16x8 war = *(const bf16x8*)(Wr + (32 * et + r32) * 64 + 16 * kk + 8 * hi), wai = *(const bf16x8*)(Wi + (32 * et + r32) * 64 + 16 * kk + 8 * hi);
                    accr = __builtin_amdgcn_mfma_f32_32x32x16_bf16(war, xb, accr, 0, 0, 0);
                    acci = __builtin_amdgcn_mfma_f32_32x32x16_bf16(wai, xb, acci, 0, 0, 0); }
                const int tok = 32 * tt + r32, t = t0 + tok; const bool valid = tok < nvalid;
                float av[16], uv[16];
#pragma unroll
                for (int r = 0; r < 16; ++r) { const int ch = 64 * n + 32 * et + (r & 3) + 8 * (r >> 2) + 4 * hi;
                    const float xcv = bf2f(*(const LAS unsigned short*)(lds + tok * XC_STRIDE + ch * 2));
                    const float rg = __builtin_amdgcn_rcpf(1.0f + __expf(-(accr[r] + Pbrg[ch]))), ig = __builtin_amdgcn_rcpf(1.0f + __expf(-(acci[r] + Pbig[ch])));
                    const float la = rg * Plsl[ch]; float aa = __expf(la); float mult = __builtin_amdgcn_sqrtf(fmaxf(__builtin_fmaf(-aa, aa, 1.0f), 0.f)); if (t == 0) mult = 1.0f;
                    float uu = mult * ig * xcv; if (!valid) { aa = 1.0f; uu = 0.f; }
                    av[r] = aa; uv[r] = uu; }
#define DPP_F(OLD, X, CTRL, RM) __builtin_amdgcn_update_dpp((OLD), (X), (CTRL), (RM), 0xf, false)
#define SCAN_STEP(CTRL, RM) do { _Pragma("unroll") for (int r = 0; r < 16; ++r) { const float ap = DPP_F(1.0f, av[r], CTRL, RM), up = DPP_F(0.0f, uv[r], CTRL, RM); uv[r] = __builtin_fmaf(av[r], up, uv[r]); av[r] = av[r] * ap; } } while (0)
                SCAN_STEP(0x111, 0xf); SCAN_STEP(0x112, 0xf); SCAN_STEP(0x114, 0xf); SCAN_STEP(0x118, 0xf);
                SCAN_STEP(0x142, 0xa);
#undef SCAN_STEP
#undef DPP_F
                if (tt == 0) {
#pragma unroll
                    for (int r = 0; r < 16; ++r) { A0[r] = __shfl(av[r], 31, 32); H0[r] = __shfl(uv[r], 31, 32); }
                } else {
#pragma unroll
                    for (int r = 0; r < 16; ++r) { uv[r] = av[r] * H0[r] + uv[r]; av[r] = av[r] * A0[r]; }
                }
                if (valid) {
#pragma unroll
                    for (int g4 = 0; g4 < 4; ++g4) { const int ch0 = 64 * n + 32 * et + 8 * g4 + 4 * hi; const size_t off = (size_t)(b * TT + t) * 512 + ch0;
                        *(u32x2*)(a.HL + off) = (u32x2){cvtpk(uv[4 * g4], uv[4 * g4 + 1]), cvtpk(uv[4 * g4 + 2], uv[4 * g4 + 3])};
                        *(u32x2*)(a.CA + off) = (u32x2){cvtpk(av[4 * g4], av[4 * g4 + 1]), cvtpk(av[4 * g4 + 2], av[4 * g4 + 3])}; }
                }
                if (tt == ntt - 1 && r32 == 31) {
#pragma unroll
                    for (int g4 = 0; g4 < 4; ++g4) { const int ch0 = 64 * n + 32 * et + 8 * g4 + 4 * hi; const size_t off = (size_t)(b * NCH + c) * 512 + ch0;
                        *(f32x4*)(a.SUMA + off) = (f32x4){av[4 * g4], av[4 * g4 + 1], av[4 * g4 + 2], av[4 * g4 + 3]};
                        *(f32x4*)(a.SUMH + off) = (f32x4){uv[4 * g4], uv[4 * g4 + 1], uv[4 * g4 + 2], uv[4 * g4 + 3]}; }
                }
            }
        }

__device__ __forceinline__ void rec_local_phase(LAS unsigned char* lds, const RecArgs& a, int bid, int G, int tid_in) {
    int tid = tid_in; asm volatile("" : "+v"(tid));
    const int lane = tid & 63, wid = __builtin_amdgcn_readfirstlane(tid >> 6), r32 = lane & 31, hi = lane >> 5;
    LAS float* Pbrg = (LAS float*)(lds + 66560); LAS float* Pbig = Pbrg + 512; LAS float* Plsl = Pbig + 512;
    Pbrg[tid] = a.b_rg[tid]; Pbig[tid] = a.b_ig[tid]; { const float L = a.lruL[tid]; Plsl[tid] = -8.0f * log1pf(__expf(-L)); }
    const bf16_t* Wr = a.wgt + (size_t)wid * 4096; const bf16_t* Wi = Wr + 8 * 4096;
    __syncthreads();
    for (int item = bid; item < NBATCH * NCH; item += G) {
        const int b = item < 512 ? (item >> 7) : (item - 512), c = item < 512 ? (item & 127) : 128, t0 = 64 * c, nvalid = (TT - t0) < 64 ? (TT - t0) : 64;
        if (8 * wid < nvalid) {
            float cw[4][8], cb[8];
#pragma unroll
            for (int k = 0; k < 4; ++k) { const f32x4 w0 = *(const f32x4*)(a.conv_w + k * 512 + 8 * lane), w1 = *(const f32x4*)(a.conv_w + k * 512 + 8 * lane + 4);
#pragma unroll
                for (int j = 0; j < 4; ++j) { cw[k][j] = w0[j]; cw[k][4 + j] = w1[j]; } }
            { const f32x4 w0 = *(const f32x4*)(a.conv_b + 8 * lane), w1 = *(const f32x4*)(a.conv_b + 8 * lane + 4);
#pragma unroll
                for (int j = 0; j < 4; ++j) { cb[j] = w0[j]; cb[4 + j] = w1[j]; } }
            u32x4 raws[11];
#pragma unroll
            for (int k = 0; k < 11; ++k) { const int t = t0 + 8 * wid - 3 + k; raws[k] = (u32x4){0u, 0u, 0u, 0u};
                if (t >= 0 && t < TT) raws[k] = *(const u32x4*)(a.PJ + (size_t)(b * TT + t) * NIN + 1536 + 8 * lane); }
            float win[3][8];
#pragma unroll
            for (int k = 0; k < 3; ++k) {
#pragma unroll
                for (int j = 0; j < 4; ++j) { win[k][2 * j] = __uint_as_float(raws[k][j] << 16); win[k][2 * j + 1] = __uint_as_float(raws[k][j] & 0xffff0000u); } }
#pragma unroll
            for (int i = 0; i < 8; ++i) { const u32x4 raw = raws[3 + i];
                float cur[8], o[8];
#pragma unroll
                for (int j = 0; j < 4; ++j) { cur[2 * j] = __uint_as_float(raw[j] << 16); cur[2 * j + 1] = __uint_as_float(raw[j] & 0xffff0000u); }
#pragma unroll
                for (int j = 0; j < 8; ++j) { o[j] = cb[j] + cw[0][j] * win[0][j] + cw[1][j] * win[1][j] + cw[2][j] * win[2][j] + cw[3][j] * cur[j]; win[0][j] = win[1][j]; win[1][j] = win[2][j]; win[2][j] = cur[j]; }
                u32x4 w; w.x = cvtpk(o[0], o[1]); w.y = cvtpk(o[2], o[3]); w.z = cvtpk(o[4], o[5]); w.w = cvtpk(o[6], o[7]);
                *(LAS u32x4*)(lds + (8 * wid + i) * XC_STRIDE + lane * 16) = w; }
        }
        __syncthreads();
        const int n = wid;
        rec_et(lds, a, Wr, Wi, 0, n, r32, hi, b, c, t0, nvalid, Pbrg, Pbig, Plsl);
        rec_et(lds, a, Wr, Wi, 1, n, r32, hi, b, c, t0, nvalid, Pbrg, Pbig, Plsl);
        __syncthreads();
    }
}

__device__ __forceinline__ float gelu_tanh(float x) {
    const float u = 0.7978845608028654f * (x + 0.044715f * x * x * x);
    const float e = __expf(2.0f * u);
    const float th = 1.0f - 2.0f * __builtin_amdgcn_rcpf(e + 1.0f);
    return 0.5f * x * (1.0f + th);
}
__device__ __forceinline__ void rec_fix_phase(LAS unsigned char* lds, const RecArgs& a, int bid, int G, int tid_in) {
    int tid = tid_in; asm volatile("" : "+v"(tid));
    const int lane = tid & 63, wid = __builtin_amdgcn_readfirstlane(tid >> 6);
    LAS float* Lc = (LAS float*)lds;
    for (int item = bid; item < NBATCH * NCH; item += G) {
        const int b = item < 512 ? (item >> 7) : (item - 512), c = item < 512 ? (item & 127) : 128, t0 = 64 * c, nvalid = (TT - t0) < 64 ? (TT - t0) : 64;
        float carry = 0.f;
        {
            const float* pa = a.SUMA + (size_t)(b * NCH) * 512 + tid; const float* ph = a.SUMH + (size_t)(b * NCH) * 512 + tid;
            int cc = 0;
            for (; cc + 32 <= c; cc += 32) { float A_[32], H_[32];
#pragma unroll
                for (int i = 0; i < 32; ++i) { A_[i] = pa[(size_t)(cc + i) * 512]; H_[i] = ph[(size_t)(cc + i) * 512]; }
#pragma unroll
                for (int i = 0; i < 32; ++i) carry = A_[i] * carry + H_[i]; }
            for (; cc + 8 <= c; cc += 8) { float A_[8], H_[8];
#pragma unroll
                for (int i = 0; i < 8; ++i) { A_[i] = pa[(size_t)(cc + i) * 512]; H_[i] = ph[(size_t)(cc + i) * 512]; }
#pragma unroll
                for (int i = 0; i < 8; ++i) carry = A_[i] * carry + H_[i]; }
            for (; cc < c; ++cc) carry = pa[(size_t)cc * 512] * carry + ph[(size_t)cc * 512];
        }
        Lc[tid] = carry;
        __syncthreads();
        float cv[8], gg[8];
        { const f32x4 c0 = *(const LAS f32x4*)(Lc + 8 * lane), c1 = *(const LAS f32x4*)(Lc + 8 * lane + 4);
          const f32x4 g0 = *(const f32x4*)(a.recg + 8 * lane), g1 = *(const f32x4*)(a.recg + 8 * lane + 4);
#pragma unroll
          for (int j = 0; j < 4; ++j) { cv[j] = c0[j]; cv[4 + j] = c1[j]; gg[j] = g0[j]; gg[4 + j] = g1[j]; } }
        if (8 * wid < nvalid) {
        u32x4 hls[8], cas[8], gts[8];
#pragma unroll
        for (int i = 0; i < 8; ++i) { const size_t m = (size_t)(b * TT + t0 + 8 * wid + i);
            hls[i] = *(const u32x4*)(a.HL + m * 512 + 8 * lane); cas[i] = *(const u32x4*)(a.CA + m * 512 + 8 * lane); gts[i] = *(const u32x4*)(a.PJ + m * NIN + 2048 + 8 * lane); }
#pragma unroll
        for (int i = 0; i < 8; ++i) { const int tok = 8 * wid + i;
            const size_t m = (size_t)(b * TT + t0 + tok);
            const u32x4 hl = hls[i], ca = cas[i], gt = gts[i];
            float y[8]; float ss = 0.f;
#pragma unroll
            for (int j = 0; j < 4; ++j) {
                const float h0 = __uint_as_float(hl[j] << 16) + __uint_as_float(ca[j] << 16) * cv[2 * j], h1 = __uint_as_float(hl[j] & 0xffff0000u) + __uint_as_float(ca[j] & 0xffff0000u) * cv[2 * j + 1];
                y[2 * j] = h0 * gelu_tanh(__uint_as_float(gt[j] << 16)); y[2 * j + 1] = h1 * gelu_tanh(__uint_as_float(gt[j] & 0xffff0000u));
                ss += y[2 * j] * y[2 * j] + y[2 * j + 1] * y[2 * j + 1]; }
#pragma unroll
            for (int o = 1; o < 64; o <<= 1) ss += __shfl_xor(ss, o);
            const float rn = rsqrtf(ss * (1.0f / 512.0f) + EPS);
            u32x4 w; w.x = cvtpk(y[0] * rn * gg[0], y[1] * rn * gg[1]); w.y = cvtpk(y[2] * rn * gg[2], y[3] * rn * gg[3]);
            w.z = cvtpk(y[4] * rn * gg[4], y[5] * rn * gg[5]); w.w = cvtpk(y[6] * rn * gg[6], y[7] * rn * gg[7]);
            *(u32x4*)(a.MIX + m * DM + 512 + 8 * lane) = w; }
        }
        __syncthreads();
    }
}

struct AttnArgs { const bf16_t* PJ; bf16_t* MIX; const float* subg; unsigned* ctr; float lam, shift, osc; };
constexpr int KSTR = 272, VSTR = 320, KBUF = 64 * KSTR, VBUF = 64 * VSTR, A_K0 = 0, A_V0 = 2 * KBUF, A_RING = 2 * KBUF + 3 * VBUF, SSTR = 132;
constexpr int NUNITS = 16 * NQB;

__device__ __forceinline__ void attn_phase(LAS unsigned char* lds, const AttnArgs& a, int tid_in) {
    int tid = tid_in; asm volatile("" : "+v"(tid));
    const int lane = tid & 63, wid = __builtin_amdgcn_readfirstlane(tid >> 6), r32 = lane & 31, hi = lane >> 5, rg = wid & 3, c = wid >> 2;
    LAS unsigned* sU = (LAS unsigned*)(lds + LDS_MISC);
    LAS float* LW = (LAS float*)(lds + LDS_MISC + 256) + wid * 32;
    const int skey = tid >> 4, sch = tid & 15;
    const int q4 = (lane & 15) >> 2, p4 = lane & 3, ch2 = (lane >> 4) & 1;
    const unsigned xcc = xb_xcc_id() & 7u;
    unsigned dead = 0u;
#define A_FETCH(res) do { res = 0xffffffffu; \
            for (unsigned i_ = 0; i_ < 8u && res == 0xffffffffu; ++i_) { const unsigned j_ = (xcc + i_) & 7u; \
                if (dead & (1u << j_)) continue; \
                const unsigned k_ = atomicAdd(a.ctr + 32 * j_, 1u); \
                if (k_ < 2u * NQB) res = (j_ << 8) | k_; else dead |= 1u << j_; } } while (0)
#define A_LOAD(t) do { _Pragma("unroll") for (int j_ = 0; j_ < 2; ++j_) { kreg[j_] = *(const u32x4*)(kg + (size_t)(64 * (t) + 32 * j_) * NIN); vreg[j_] = *(const u32x4*)(kg + 512 + (size_t)(64 * (t) + 32 * j_) * NIN); } } while (0)
#define A_STORE(kbi, vbi) do { _Pragma("unroll") for (int j_ = 0; j_ < 2; ++j_) { *(LAS u32x4*)(lds + A_K0 + (kbi) * KBUF + (skey + 32 * j_) * KSTR + sch * 16) = kreg[j_]; *(LAS u32x4*)(lds + A_V0 + (vbi) * VBUF + (skey + 32 * j_) * VSTR + sch * 16) = vreg[j_]; } } while (0)
#define A_UNIT_PRELOAD(U, QB, B_, H_, NT_, ROWB) do { const int qj_ = (int)((U) >> 8), qk_ = (int)((U) & 255u); \
            QB = (NQB - 1) - (qk_ >> 1); const int bh_ = 2 * qj_ + (qk_ & 1); B_ = bh_ >> 2; H_ = bh_ & 3; \
            NT_ = (2 * QB + 2) < NCH ? (2 * QB + 2) : NCH; ROWB = (size_t)B_ * TT; \
            int tp_ = tid; asm volatile("" : "+v"(tp_));       \
            const unsigned qoff_ = (unsigned)((32 * ((tp_ >> 6) & 3) + (tp_ & 31)) * NIN + (tp_ >> 8) * 64 + 8 * ((tp_ >> 5) & 1)), koff_ = (unsigned)((tp_ >> 4) * NIN + (tp_ & 15) * 8); \
            { const bf16_t* qp_ = a.PJ + ((ROWB + 128 * QB) * NIN + H_ * 128) + qoff_; \
              _Pragma("unroll") for (int d0 = 0; d0 < 4; ++d0) qr[d0] = *(const bf16x8*)(qp_ + 16 * d0); } \
            kg = a.PJ + (ROWB * NIN + 512 + H_ * 128) + koff_; \
            A_LOAD(0); } while (0)
    bf16x8 qr[4]; const bf16_t* kg; u32x4 kreg[2], vreg[2];
    int qb, b, h, NT; size_t rowb;
    {
        if (tid == 0) { unsigned res; A_FETCH(res); *sU = res; }
        __syncthreads();
        const unsigned u0 = *sU;
        __syncthreads();
        if (u0 == 0xffffffffu) return;
        A_UNIT_PRELOAD(u0, qb, b, h, NT, rowb);
    }
    for (;;) {
        A_STORE(0, 0);
        A_LOAD(1);
        __syncthreads();
        f32x16 o[4]; o[0] = f32x16{}; o[1] = f32x16{}; o[2] = f32x16{}; o[3] = f32x16{};
        float lsum = 0.f;
#define SB() __builtin_amdgcn_sched_barrier(0)
#define MF(A, B, C) __builtin_amdgcn_mfma_f32_32x32x16_bf16(A, B, C, 0, 0, 0)
#define VREAD(buf, sl) do { _Pragma("unroll") for (int db_ = 0; db_ < 4; ++db_) { \
            const s16x4 lo_ = __builtin_bit_cast(s16x4, __builtin_amdgcn_ds_read_tr16_b64_v4i16((LAS s16x4*)(vb + 16 * (sl) * VSTR + db_ * 64))); \
            const s16x4 hh_ = __builtin_bit_cast(s16x4, __builtin_amdgcn_ds_read_tr16_b64_v4i16((LAS s16x4*)(vb + (16 * (sl) + 8) * VSTR + db_ * 64))); \
            buf[db_] = (bf16x8){lo_[0], lo_[1], lo_[2], lo_[3], hh_[0], hh_[1], hh_[2], hh_[3]}; } } while (0)
#define EX4(P, B) do { P[B] = __builtin_amdgcn_exp2f(P[B]); P[B + 1] = __builtin_amdgcn_exp2f(P[B + 1]); P[B + 2] = __builtin_amdgcn_exp2f(P[B + 2]); P[B + 3] = __builtin_amdgcn_exp2f(P[B + 3]); } while (0)
#define PK4(W, P, B) do { W[0] = cvtpk(P[B], P[B + 1]); W[1] = cvtpk(P[B + 2], P[B + 3]); W[2] = cvtpk(P[B + 4], P[B + 5]); W[3] = cvtpk(P[B + 6], P[B + 7]); } while (0)
#define SUM8(P, B) do { lsum += ((P[B] + P[B + 1]) + (P[B + 2] + P[B + 3])) + ((P[B + 4] + P[B + 5]) + (P[B + 6] + P[B + 7])); } while (0)
#define AS_BF(W) __builtin_bit_cast(bf16x8, W)
#define A_QK(t) \
            const LAS unsigned char* kb = lds + A_K0 + ((t) & 1) * KBUF + r32 * KSTR + (c * 64 + 8 * hi) * 2; \
            bf16x8 kf[8]; \
            _Pragma("unroll") for (int d0 = 0; d0 < 4; ++d0) { kf[2 * d0] = *(const LAS bf16x8*)(kb + d0 * 32); kf[2 * d0 + 1] = *(const LAS bf16x8*)(kb + 32 * KSTR + d0 * 32); } \
            f32x16 p0, p1; \
            p0 = MF(kf[0], qr[0], cinit); p1 = MF(kf[1], qr[0], cinit); \
            _Pragma("unroll") for (int d0 = 1; d0 < 4; ++d0) { p0 = MF(kf[2 * d0], qr[d0], p0); p1 = MF(kf[2 * d0 + 1], qr[d0], p1); }
#define A_MASK(P, t, OFF) do { const int qrel_ = 128 * qb + 32 * rg + r32 - 64 * (t) - (OFF) - 4 * hi; _Pragma("unroll") for (int r = 0; r < 16; ++r) { if ((r & 3) + 8 * (r >> 2) > qrel_) P[r] = 0.f; } } while (0)
#define A_FIRST(MASKED, t) do { A_QK(t) \
            EX4(p0, 0); EX4(p0, 4); EX4(p0, 8); EX4(p0, 12); EX4(p1, 0); EX4(p1, 4); EX4(p1, 8); EX4(p1, 12); \
            if (MASKED) { A_MASK(p0, t, 0); A_MASK(p1, t, 32); } \
            SUM8(p0, 0); SUM8(p0, 8); SUM8(p1, 0); SUM8(p1, 8); \
            PK4(pwp0, p0, 0); PK4(pwp1, p0, 8); PK4(pwp2, p1, 0); PK4(pwp3, p1, 8); } while (0)
#define VRD1(dst, sl, db) do { \
            const s16x4 lo_ = __builtin_bit_cast(s16x4, __builtin_amdgcn_ds_read_tr16_b64_v4i16((LAS s16x4*)(vb + 16 * (sl) * VSTR + (db) * 64))); \
            const s16x4 hh_ = __builtin_bit_cast(s16x4, __builtin_amdgcn_ds_read_tr16_b64_v4i16((LAS s16x4*)(vb + (16 * (sl) + 8) * VSTR + (db) * 64))); \
            dst = (bf16x8){lo_[0], lo_[1], lo_[2], lo_[3], hh_[0], hh_[1], hh_[2], hh_[3]}; } while (0)
#define A_PIPE(MASKED, t, vslot) do { A_QK(t) \
            const LAS unsigned char* vb = lds + A_V0 + (vslot) * VBUF + (4 * hi + q4) * VSTR + (16 * ch2 + 4 * p4) * 2; \
            bf16x8 vf[4]; \
            VREAD(vf, 0); SB(); \
            __builtin_amdgcn_s_setprio(1); \
            o[0] = MF(AS_BF(pwp0), vf[0], o[0]); VRD1(vf[0], 1, 0); EX4(p0, 0); SB(); \
            o[1] = MF(AS_BF(pwp0), vf[1], o[1]); VRD1(vf[1], 1, 1); EX4(p0, 4); SB(); \
            o[2] = MF(AS_BF(pwp0), vf[2], o[2]); VRD1(vf[2], 1, 2); EX4(p0, 8); SB(); \
            o[3] = MF(AS_BF(pwp0), vf[3], o[3]); VRD1(vf[3], 1, 3); EX4(p0, 12); if (MASKED) A_MASK(p0, t, 0); SB(); \
            o[0] = MF(AS_BF(pwp1), vf[0], o[0]); VRD1(vf[0], 2, 0); EX4(p1, 0); SB(); \
            o[1] = MF(AS_BF(pwp1), vf[1], o[1]); VRD1(vf[1], 2, 1); EX4(p1, 4); SB(); \
            o[2] = MF(AS_BF(pwp1), vf[2], o[2]); VRD1(vf[2], 2, 2); EX4(p1, 8); SB(); \
            o[3] = MF(AS_BF(pwp1), vf[3], o[3]); VRD1(vf[3], 2, 3); EX4(p1, 12); if (MASKED) A_MASK(p1, t, 32); SB(); \
            o[0] = MF(AS_BF(pwp2), vf[0], o[0]); VRD1(vf[0], 3, 0); PK4(pwp0, p0, 0); SB(); \
            o[1] = MF(AS_BF(pwp2), vf[1], o[1]); VRD1(vf[1], 3, 1); PK4(pwp1, p0, 8); SB(); \
            o[2] = MF(AS_BF(pwp2), vf[2], o[2]); VRD1(vf[2], 3, 2); SB(); \
            o[3] = MF(AS_BF(pwp2), vf[3], o[3]); VRD1(vf[3], 3, 3); SB(); \
            o[0] = MF(AS_BF(pwp3), vf[0], o[0]); o[1] = MF(AS_BF(pwp3), vf[1], o[1]); o[2] = MF(AS_BF(pwp3), vf[2], o[2]); o[3] = MF(AS_BF(pwp3), vf[3], o[3]); \
            __builtin_amdgcn_s_setprio(0); \
            PK4(pwp2, p1, 0); PK4(pwp3, p1, 8); \
            SUM8(p0, 0); SUM8(p0, 8); SUM8(p1, 0); SUM8(p1, 8); } while (0)
#define A_DRAIN(vslot) do { \
            const LAS unsigned char* vb = lds + A_V0 + (vslot) * VBUF + (4 * hi + q4) * VSTR + (16 * ch2 + 4 * p4) * 2; \
            bf16x8 vf[4]; \
            VREAD(vf, 0); \
            o[0] = MF(AS_BF(pwp0), vf[0], o[0]); VRD1(vf[0], 1, 0); o[1] = MF(AS_BF(pwp0), vf[1], o[1]); VRD1(vf[1], 1, 1); o[2] = MF(AS_BF(pwp0), vf[2], o[2]); VRD1(vf[2], 1, 2); o[3] = MF(AS_BF(pwp0), vf[3], o[3]); VRD1(vf[3], 1, 3); SB(); \
            o[0] = MF(AS_BF(pwp1), vf[0], o[0]); VRD1(vf[0], 2, 0); o[1] = MF(AS_BF(pwp1), vf[1], o[1]); VRD1(vf[1], 2, 1); o[2] = MF(AS_BF(pwp1), vf[2], o[2]); VRD1(vf[2], 2, 2); o[3] = MF(AS_BF(pwp1), vf[3], o[3]); VRD1(vf[3], 2, 3); SB(); \
            o[0] = MF(AS_BF(pwp2), vf[0], o[0]); VRD1(vf[0], 3, 0); o[1] = MF(AS_BF(pwp2), vf[1], o[1]); VRD1(vf[1], 3, 1); o[2] = MF(AS_BF(pwp2), vf[2], o[2]); VRD1(vf[2], 3, 2); o[3] = MF(AS_BF(pwp2), vf[3], o[3]); VRD1(vf[3], 3, 3); SB(); \
            o[0] = MF(AS_BF(pwp3), vf[0], o[0]); o[1] = MF(AS_BF(pwp3), vf[1], o[1]); o[2] = MF(AS_BF(pwp3), vf[2], o[2]); o[3] = MF(AS_BF(pwp3), vf[3], o[3]); } while (0)
        f32x16 cinit;
#pragma unroll
        for (int r = 0; r < 16; ++r) cinit[r] = -a.shift;
        asm volatile("" : "+v"(cinit));
        asm volatile("" : "+v"(qr[0]), "+v"(qr[1]), "+v"(qr[2]), "+v"(qr[3]));
        const int NTM = (2 * qb) < NT ? (2 * qb) : NT;
        u32x4 pwp0, pwp1, pwp2, pwp3;
        if (NTM == 0) A_FIRST(true, 0); else A_FIRST(false, 0);
        A_STORE(1, 1);
        if (2 < NT) A_LOAD(2);
        __syncthreads();
        int t = 1, vp = 0, vn = 2;
        for (; t < NTM; ++t) {
            A_PIPE(false, t, vp);
            A_STORE((t + 1) & 1, vn);
            if (t + 2 < NT) A_LOAD(t + 2);
            __syncthreads();
            vp = (vp == 2) ? 0 : vp + 1; vn = (vn == 2) ? 0 : vn + 1;
        }
        for (; t < NT; ++t) {
            A_PIPE(true, t, vp);
            if (t + 1 < NT) A_STORE((t + 1) & 1, vn);
            if (t + 2 < NT) A_LOAD(t + 2);
            __syncthreads();
            vp = (vp == 2) ? 0 : vp + 1; vn = (vn == 2) ? 0 : vn + 1;
        }
        A_DRAIN(vp);
        __syncthreads();
#undef A_QK
#undef A_MASK
#undef A_FIRST
#undef A_PIPE
#undef A_DRAIN
#undef VRD1
#undef SB
#undef MF
#undef VREAD
#undef EX4
#undef PK4
#undef SUM8
#undef AS_BF
        lsum += __shfl_xor(lsum, 32);
        if (hi == 0) LW[r32] = lsum;
        asm volatile("s_waitcnt lgkmcnt(0)" ::: "memory");
        LAS float* S = (LAS float*)lds;
        float li[16];
#pragma unroll
        for (int r = 0; r < 16; ++r) li[r] = (c == 0 ? 1.0f : a.lam) / LW[(r & 3) + 8 * (r >> 2) + 4 * hi];
        if (tid == 0) { unsigned res; A_FETCH(res); *sU = res; }
        if (c == 1) {
#pragma unroll
            for (int db = 0; db < 4; ++db)
#pragma unroll
                for (int r = 0; r < 16; ++r) S[(32 * rg + (r & 3) + 8 * (r >> 2) + 4 * hi) * SSTR + 32 * db + r32] = o[db][r] * li[r];
        }
        __syncthreads();
        const unsigned un = *sU;
        int nqb = 0, nb = 0, nh = 0, nNT = 0; size_t nrowb = 0;
        if (un != 0xffffffffu) A_UNIT_PRELOAD(un, nqb, nb, nh, nNT, nrowb);
        if (c == 0) {
#pragma unroll
            for (int db = 0; db < 4; ++db)
#pragma unroll
                for (int r = 0; r < 16; ++r) { LAS float* sp = S + (32 * rg + (r & 3) + 8 * (r >> 2) + 4 * hi) * SSTR + 32 * db + r32; *sp = o[db][r] * li[r] - *sp; }
        }
        __syncthreads();
        {
            const int row = 16 * wid + (lane >> 2), qd = lane & 3, tq = 128 * qb + row;
            f32x4 v[8]; float ss = 0.f;
#pragma unroll
            for (int j = 0; j < 8; ++j) { v[j] = *(const LAS f32x4*)(S + row * SSTR + 32 * qd + 4 * j); ss += (v[j][0] * v[j][0] + v[j][1] * v[j][1]) + (v[j][2] * v[j][2] + v[j][3] * v[j][3]); }
            ss += __shfl_xor(ss, 1); ss += __shfl_xor(ss, 2);
            const float rn = rsqrtf(ss * (1.0f / 128.0f) + EPS) * a.osc;
            if (tq < TT) {
                bf16_t* op = a.MIX + (rowb + tq) * DM + h * 128 + 32 * qd;
#pragma unroll
                for (int j = 0; j < 4; ++j) { const f32x4 g0 = *(const f32x4*)(a.subg + 32 * qd + 8 * j), g1 = *(const f32x4*)(a.subg + 32 * qd + 8 * j + 4);
                    *(u32x4*)(op + 8 * j) = pack8(v[2 * j] * rn * g0, v[2 * j + 1] * rn * g1); }
            }
        }
        __syncthreads();
        if (un == 0xffffffffu) break;
        qb = nqb; b = nb; h = nh; NT = nNT; rowb = nrowb;
    }
#undef A_FETCH
#undef A_UNIT_PRELOAD
#undef A_LOAD
#undef A_STORE
}

__global__ void __launch_bounds__(512) hymba_fwd(Params p) {
    extern __shared__ __attribute__((aligned(16))) unsigned char lds_raw[];
    LAS unsigned char* lds = (LAS unsigned char*)lds_raw;
    cg::grid_group grid = cg::this_grid();
    if (p.ws == nullptr) grid.sync();
    const int tid = threadIdx.x, bid = blockIdx.x, G = gridDim.x;
    if (tid < 4) ((LAS unsigned*)(lds + LDS_MISC + 64))[tid] = 0u;
    __syncthreads();
    const XcdBarrier xbar = xcd_barrier_post((unsigned*)(p.ws + WS_CTL) + 1024, (volatile LAS unsigned*)(lds + LDS_MISC + 64));
    unsigned char* ws = p.ws;
    bf16_t* HB = (bf16_t*)(ws + WS_HB); bf16_t* PJ = (bf16_t*)(ws + WS_PJ); bf16_t* MIX = (bf16_t*)(ws + WS_MIX); bf16_t* ACT = (bf16_t*)(ws + WS_ACT);
    float* SSQ = (float*)(ws + WS_SSQ);

#ifndef NO_PRO
    prologue(p, lds, bid, G, tid);
#endif
#ifdef PROBE_SYNC10
    for (int i_ = 0; i_ < 10; ++i_) grid.sync();
#endif
#ifdef PROBE_PRO2
    __syncthreads(); prologue(p, lds, bid, G, tid);
#endif

    for (int l = 0; ; ++l) {
        xcd_barrier(xbar);
        if (l == 2) break;
        unsigned char* wl = ws + WS_W + (size_t)l * W_LAYER;
        {
            pg8::Gemm g{HB, (const bf16_t*)(wl + W_IN), MMAIN, NIN, DM}; pg8::StaticOrder S; S.init(MMAIN, NIN, G, bid);
            EpiIn E{PJ, SSQ, p.in[4] + l * 64, p.in[5] + l * 64};
#ifndef NO_G1
            pg8::gemm_phase<EpiIn, pg8::StaticOrder, true, true>(lds, g, S, E);
#endif
            gemm_tail<EpiIn, DM>(lds, g.A, g.Bt, g.N, E, bid, G, tid);
#ifdef PROBE_G1X2
            pg8::gemm_phase<EpiIn, pg8::StaticOrder, true, true>(lds, g, S, E);
#endif
        }
        xcd_barrier(xbar);
        RecArgs ra{PJ, (bf16_t*)(ws + WS_HL), (bf16_t*)(ws + WS_CA), (float*)(ws + WS_SUMA), (float*)(ws + WS_SUMH), MIX,
                   p.in[11] + l * 4 * 512, p.in[12] + l * 512, p.in[14] + l * 512, p.in[16] + l * 512, p.in[17] + l * 512, p.in[18] + l * 512, (const bf16_t*)(ws + WS_WG) + (size_t)l * 2 * 8 * 4096};
#ifndef NO_RECL
        rec_local_phase(lds, ra, bid, G, tid);
#endif
#ifdef PROBE_RECL2
        rec_local_phase(lds, ra, bid, G, tid);
#endif
        xcd_barrier(xbar);
#ifndef NO_RECF
        rec_fix_phase(lds, ra, bid, G, tid);
#endif
#ifdef PROBE_RECF2
        rec_fix_phase(lds, ra, bid, G, tid);
#endif
        {
            const float lam_init = (l == 0) ? 0.2f : 0.35550906759096934f;
            float d1 = 0.f, d2 = 0.f, mq = 0.f, mk = 0.f;
            for (int j = 0; j < 64; ++j) { d1 += p.in[6][l * 64 + j] * p.in[7][l * 64 + j]; d2 += p.in[8][l * 64 + j] * p.in[9][l * 64 + j];
                mq = fmaxf(mq, fabsf(p.in[4][l * 64 + j])); mk = fmaxf(mk, fabsf(p.in[5][l * 64 + j])); }
            AttnArgs aa{PJ, MIX, p.in[10] + l * 128, (unsigned*)(ws + WS_CTL) + 512 * l, __expf(d1) - __expf(d2) + lam_init, 8.0f * 1.4426950408889634f * mq * mk, 1.0f - lam_init};
#ifndef NO_ATTN
            attn_phase(lds, aa, tid);
#endif
#ifdef PROBE_ATTN2
            { AttnArgs ab = aa; ab.ctr = (unsigned*)(ws + WS_CTL) + 512 * l + 256; attn_phase(lds, ab, tid); }
#endif
        }
        xcd_barrier(xbar);
        {
            pg8::Gemm g{MIX, (const bf16_t*)(wl + W_O), MMAIN, DM, DM}; pg8::StaticOrder S; S.init(MMAIN, DM, G, bid);
            EpiRes E{p.out, HB, SSQ, 0};
#ifndef NO_G3
            pg8::gemm_phase<EpiRes, pg8::StaticOrder, true, true>(lds, g, S, E);
#endif
            gemm_tail<EpiRes, DM>(lds, g.A, g.Bt, g.N, E, bid, G, tid);
        }
        xcd_barrier(xbar);
        {
            pg8::Gemm g{HB, (const bf16_t*)(wl + W_GU), MMAIN, 2 * DFF, DM}; pg8::StaticOrder S; S.init(MMAIN, 2 * DFF, G, bid);
            EpiGU E{ACT, SSQ};
#ifndef NO_G4
            pg8::gemm_phase<EpiGU, pg8::StaticOrder, true, true>(lds, g, S, E);
#endif
            gemm_tail<EpiGU, DM>(lds, g.A, g.Bt, g.N, E, bid, G, tid);
#ifdef PROBE_G4X2
            pg8::gemm_phase<EpiGU, pg8::StaticOrder, true, true>(lds, g, S, E);
#endif
        }
        xcd_barrier(xbar);
        {
            pg8::Gemm g{ACT, (const bf16_t*)(wl + W_D), MMAIN, DM, DFF}; pg8::StaticOrder S; S.init(MMAIN, DM, G, bid);
            EpiRes E{p.out, HB, SSQ, l == 1 ? 1 : 0};
#ifndef NO_G5
            pg8::gemm_phase<EpiRes, pg8::StaticOrder, true, true>(lds, g, S, E);
#endif
            gemm_tail<EpiRes, DFF>(lds, g.A, g.Bt, g.N, E, bid, G, tid);
        }
    }
}

extern "C" void kernel_launch(void* const* d_in, const int* in_sizes, int n_in, void* d_out, int out_size, void* d_ws, size_t ws_size, hipStream_t stream) {
    static int grid = 0;
    if (grid == 0) {
        if (n_in != 23 || ws_size < WS_END) { fprintf(stderr, "kernel_launch: unexpected inputs (n_in %d, ws %zu)\n", n_in, ws_size); grid = -1; return; }
        int dev = 0, cus = 0, per_cu = 0;
        hipGetDevice(&dev); hipDeviceGetAttribute(&cus, hipDeviceAttributeMultiprocessorCount, dev);
        if (hipFuncSetAttribute((const void*)hymba_fwd, hipFuncAttributeMaxDynamicSharedMemorySize, LDS_BYTES) != hipSuccess) { fprintf(stderr, "kernel_launch: hipFuncSetAttribute failed\n"); grid = -1; return; }
        if (hipOccupancyMaxActiveBlocksPerMultiprocessor(&per_cu, (const void*)hymba_fwd, 512, LDS_BYTES) != hipSuccess || per_cu < 1) { fprintf(stderr, "kernel_launch: occupancy query says %d\n", per_cu); per_cu = 1; }
        (void)hipGetLastError();
        grid = cus;
        if (grid > 256) grid = 256;
    }
    if (grid < 0) return;
    hipMemsetAsync((char*)d_ws + WS_CTL, 0, CTL_BYTES, stream);
    Params p{};
    for (int i = 0; i < 23; ++i) p.in[i] = (const float*)d_in[i];
    p.out = (float*)d_out; p.ws = (unsigned char*)d_ws;
    void* args[] = {&p};
    hipError_t e = hipLaunchCooperativeKernel((const void*)hymba_fwd, dim3(grid), dim3(512), args, LDS_BYTES, stream);
    if (e != hipSuccess) fprintf(stderr, "kernel_launch: cooperative launch failed: %s (grid %d)\n", hipGetErrorString(e), grid);
}
```
